# Optimizing an MI355X kernel written in HIP

```python
import math
import jax, jax.numpy as jnp
from jax import lax
import numpy as np

D_MODEL = 1024
BATCH = 4
SEQ = 8192
DEPTH = 2

PLE_DIM = 256
NORM_EPS = 1e-6

MLA_HEADS = 8
MLA_Q_LORA = 384
MLA_KV_LORA = 256
MLA_NOPE = 64
MLA_ROPE = 32
MLA_V = 64
ROPE_THETA = 10000.0
Q_BLOCK = 128

DIL_GROUPS = ((128, 1), (512, 4), (2048, 16))
DIL_HEADS = 4
DIL_HEAD_DIM = 64

N_EXPERTS = 32
TOP_K = 4
D_EXPERT = 1024
SWIGLU_LIMIT = 7.0
SWIGLU_ALPHA = 1.702
EXPERT_ROW_BLOCK = 256

N_GATES = 2
COLS_MLA = MLA_Q_LORA + MLA_KV_LORA + MLA_ROPE
COLS_DIL = len(DIL_GROUPS) * 3 * DIL_HEADS * DIL_HEAD_DIM
COLS_GATE = N_GATES * D_MODEL
IN_COLS = COLS_MLA + COLS_DIL + COLS_GATE

kernel_name = "hybrid_mla_dilated_moe_ple"


def rmsnorm(x, g):
    xf = x.astype(jnp.float32)
    y = xf * lax.rsqrt(jnp.mean(xf * xf, axis=-1, keepdims=True) + NORM_EPS)
    return (y * g.astype(jnp.float32)).astype(x.dtype)


def rope(t):
    S, R = t.shape[1], t.shape[-1]
    half = R // 2
    inv_freq = ROPE_THETA ** (-jnp.arange(half, dtype=jnp.float32) * 2.0 / R)
    ang = jnp.arange(S, dtype=jnp.float32)[:, None] * inv_freq[None, :]
    cos = jnp.cos(ang)[None, :, None, :]
    sin = jnp.sin(ang)[None, :, None, :]
    tf = t.astype(jnp.float32)
    t1, t2 = tf[..., :half], tf[..., half:]
    return jnp.concatenate([t1 * cos - t2 * sin, t1 * sin + t2 * cos], axis=-1).astype(t.dtype)


def alibi_slopes(n):
    def pow2(m):
        start = 2.0 ** (-8.0 / m)
        return [start ** (i + 1) for i in range(m)]
    if math.log2(n).is_integer():
        s = pow2(n)
    else:
        c = 2 ** int(math.floor(math.log2(n)))
        s = pow2(c) + pow2(2 * c)[0::2][: n - c]
    return np.array(sorted(s, reverse=True), dtype=np.float32)


def causal_attention(q, k, v):
    Bb, S, H, dqk = q.shape
    scale = dqk ** -0.5
    outs = []
    for start in range(0, S, Q_BLOCK):
        end = min(start + Q_BLOCK, S)
        s = jnp.einsum('bqhd,bkhd->bhqk', q[:, start:end], k[:, :end]).astype(jnp.float32) * scale
        mask = (start + jnp.arange(end - start))[:, None] >= jnp.arange(end)[None, :]
        s = jnp.where(mask, s, -jnp.inf)
        pr = jax.nn.softmax(s, axis=-1).astype(v.dtype)
        outs.append(jnp.einsum('bhqk,bkhd->bqhd', pr, v[:, :end]))
    return jnp.concatenate(outs, axis=1)


def banded_causal_attention(q, k, v, step_slopes, steps):
    G, N, H, dh = q.shape
    nb = N // steps
    qb = q.reshape(G, nb, steps, H, dh)

    def band(t):
        tb = t.reshape(G, nb, steps, H, dh)
        prev = jnp.pad(tb[:, :-1], ((0, 0), (1, 0), (0, 0), (0, 0), (0, 0)))
        return jnp.concatenate([prev, tb], axis=2)

    s = jnp.einsum('gnqhd,gnkhd->gnhqk', qb, band(k)).astype(jnp.float32) * (dh ** -0.5)
    qi = jnp.arange(steps)[:, None]
    ki = jnp.arange(2 * steps)[None, :]
    dist = qi + steps - ki
    key_pos = (jnp.arange(nb)[:, None, None] - 1) * steps + ki[None]
    valid = (dist >= 0) & (dist <= steps) & (key_pos >= 0)
    s = s - step_slopes[:, None, None] * dist.astype(jnp.float32)
    s = jnp.where(valid[None, :, None], s, -jnp.inf)
    lse = jax.nn.logsumexp(s, axis=-1)
    pr = jnp.exp(s - lse[..., None]).astype(v.dtype)
    o = jnp.einsum('gnhqk,gnkhd->gnqhd', pr, band(v))
    return o.reshape(G, N, H, dh), lse.transpose(0, 1, 3, 2).reshape(G, N, H)


def dilated_attention(q, k, v, slopes, window, dil):
    steps = window // dil
    Bb, S, H, dh = q.shape
    unit = dil * steps
    Sp = -(-S // unit) * unit

    def to_residue(t):
        t = jnp.pad(t, ((0, 0), (0, Sp - S), (0, 0), (0, 0)))
        t = t.reshape(Bb, Sp // dil, dil, H, dh).transpose(0, 2, 1, 3, 4)
        return t.reshape(Bb * dil, Sp // dil, H, dh)

    step_slopes = jnp.asarray(slopes * dil)
    o, lse = banded_causal_attention(to_residue(q), to_residue(k), to_residue(v), step_slopes, steps)
    o = o.reshape(Bb, dil, Sp // dil, H, dh).transpose(0, 2, 1, 3, 4).reshape(Bb, Sp, H, dh)[:, :S]
    lse = lse.reshape(Bb, dil, Sp // dil, H).transpose(0, 2, 1, 3).reshape(Bb, Sp, H)[:, :S]
    return o, lse


def token_mixer(h, w_in, q_norm, w_uq, kv_norm, w_ukv, w_branch_a, w_branch_b, w_out):
    Bb, S, _ = h.shape
    z = h @ w_in
    splits = np.cumsum([MLA_Q_LORA, MLA_KV_LORA, MLA_ROPE, COLS_DIL]).tolist()
    c_q, c_kv, k_r, z_dil, z_gate = jnp.split(z, splits, axis=-1)

    q = (rmsnorm(c_q, q_norm) @ w_uq).reshape(Bb, S, MLA_HEADS, MLA_NOPE + MLA_ROPE)
    kv = (rmsnorm(c_kv, kv_norm) @ w_ukv).reshape(Bb, S, MLA_HEADS, MLA_NOPE + MLA_V)
    k_rope = jnp.broadcast_to(rope(k_r[:, :, None, :]), (Bb, S, MLA_HEADS, MLA_ROPE))
    q = jnp.concatenate([q[..., :MLA_NOPE], rope(q[..., MLA_NOPE:])], axis=-1)
    k = jnp.concatenate([kv[..., :MLA_NOPE], k_rope], axis=-1)
    v = kv[..., MLA_NOPE:]
    o_a = causal_attention(q, k, v).reshape(Bb, S, MLA_HEADS * MLA_V) @ w_branch_a

    n_groups = len(DIL_GROUPS)
    zd = z_dil.reshape(Bb, S, n_groups, 3, DIL_HEADS, DIL_HEAD_DIM)
    slopes = alibi_slopes(n_groups * DIL_HEADS).reshape(n_groups, DIL_HEADS)
    outs, lses = [], []
    for gi, (window, dil) in enumerate(DIL_GROUPS):
        o_g, lse_g = dilated_attention(zd[:, :, gi, 0], zd[:, :, gi, 1], zd[:, :, gi, 2], slopes[gi], window, dil)
        outs.append(o_g)
        lses.append(lse_g)
    wts = jax.nn.softmax(jnp.stack(lses), axis=0)
    o_b = jnp.sum(wts[..., None] * jnp.stack(outs).astype(jnp.float32), axis=0).astype(h.dtype)
    o_b = o_b.reshape(Bb, S, DIL_HEADS * DIL_HEAD_DIM) @ w_branch_b

    gates = jax.nn.sigmoid(z_gate.reshape(Bb, S, N_GATES, D_MODEL))
    mixed = gates[:, :, 0] * o_a + gates[:, :, 1] * o_b
    return mixed @ w_out


def moe_ffn(h, w_router, b_router, w_gate, b_gate, w_up, b_up, w_down, b_down):
    Bb, S, D = h.shape
    T = Bb * S
    hf = h.reshape(T, D)
    logits = (hf @ w_router + b_router).astype(jnp.float32)
    top_val, top_idx = lax.top_k(logits, TOP_K)
    top_w = jax.nn.softmax(top_val, axis=-1)

    n_assign = T * TOP_K
    flat_e = top_idx.reshape(n_assign)
    flat_tok = jnp.repeat(jnp.arange(T, dtype=jnp.int32), TOP_K)
    flat_w = top_w.reshape(n_assign)
    order = jnp.argsort(flat_e)
    sorted_e = flat_e[order]
    counts = jnp.bincount(flat_e, length=N_EXPERTS)
    starts = jnp.cumsum(counts) - counts
    padded = (counts + EXPERT_ROW_BLOCK - 1) // EXPERT_ROW_BLOCK * EXPERT_ROW_BLOCK
    padded_ends = jnp.cumsum(padded)
    dest = padded_ends[sorted_e] - padded[sorted_e] + jnp.arange(n_assign) - starts[sorted_e]
    n_blocks = -(-(n_assign + N_EXPERTS * (EXPERT_ROW_BLOCK - 1)) // EXPERT_ROW_BLOCK)
    n_rows = n_blocks * EXPERT_ROW_BLOCK
    row_tok = jnp.zeros((n_rows,), jnp.int32).at[dest].set(flat_tok[order])
    row_w = jnp.zeros((n_rows,), jnp.float32).at[dest].set(flat_w[order])
    block_e = jnp.minimum(
        jnp.searchsorted(padded_ends, jnp.arange(n_blocks) * EXPERT_ROW_BLOCK, side='right'),
        N_EXPERTS - 1)

    def expert_block(args):
        tok, wt, e = args
        xb = hf[tok]
        a = jnp.minimum(xb @ w_gate[e] + b_gate[e], SWIGLU_LIMIT)
        u = jnp.clip(xb @ w_up[e] + b_up[e], -SWIGLU_LIMIT, SWIGLU_LIMIT)
        y = (a * jax.nn.sigmoid(SWIGLU_ALPHA * a)) * (u + 1.0)
        y = y @ w_down[e] + b_down[e]
        return y * wt[:, None].astype(y.dtype)

    ys = lax.map(expert_block, (row_tok.reshape(n_blocks, EXPERT_ROW_BLOCK),
                                row_w.reshape(n_blocks, EXPERT_ROW_BLOCK), block_e))
    out = jax.ops.segment_sum(ys.reshape(n_rows, D), row_tok, num_segments=T)
    return out.reshape(Bb, S, D)


def setup_inputs(seed: int = 0) -> dict:
    key = jax.random.key(seed)
    ks = iter(jax.random.split(key, 32))
    L = DEPTH

    def nrm(shape, fan_in):
        return jax.random.normal(next(ks), shape, jnp.float32) * (fan_in ** -0.5)

    def gain(shape):
        return 1.0 + 0.05 * jax.random.normal(next(ks), shape, jnp.float32)

    def bias(shape, scale):
        return scale * jax.random.normal(next(ks), shape, jnp.float32)

    return {
        "x": jax.random.normal(next(ks), (BATCH, SEQ, D_MODEL), jnp.float32),
        "p": jax.random.normal(next(ks), (DEPTH, BATCH, SEQ, PLE_DIM), jnp.float32),
        "attn_norm": gain((L, D_MODEL)),
        "w_in": nrm((L, D_MODEL, IN_COLS), D_MODEL),
        "q_norm": gain((L, MLA_Q_LORA)),
        "w_uq": nrm((L, MLA_Q_LORA, MLA_HEADS * (MLA_NOPE + MLA_ROPE)), MLA_Q_LORA),
        "kv_norm": gain((L, MLA_KV_LORA)),
        "w_ukv": nrm((L, MLA_KV_LORA, MLA_HEADS * (MLA_NOPE + MLA_V)), MLA_KV_LORA),
        "w_branch_a": nrm((L, MLA_HEADS * MLA_V, D_MODEL), MLA_HEADS * MLA_V),
        "w_branch_b": nrm((L, DIL_HEADS * DIL_HEAD_DIM, D_MODEL), DIL_HEADS * DIL_HEAD_DIM),
        "w_out": nrm((L, D_MODEL, D_MODEL), D_MODEL),
        "ffn_norm": gain((L, D_MODEL)),
        "w_router": nrm((L, D_MODEL, N_EXPERTS), D_MODEL),
        "b_router": bias((L, N_EXPERTS), 0.01),
        "w_gate": nrm((L, N_EXPERTS, D_MODEL, D_EXPERT), D_MODEL),
        "b_gate": bias((L, N_EXPERTS, D_EXPERT), 0.02),
        "w_up": nrm((L, N_EXPERTS, D_MODEL, D_EXPERT), D_MODEL),
        "b_up": bias((L, N_EXPERTS, D_EXPERT), 0.02),
        "w_down": nrm((L, N_EXPERTS, D_EXPERT, D_MODEL), D_EXPERT),
        "b_down": bias((L, N_EXPERTS, D_MODEL), 0.02),
        "ple_norm": gain((L, D_MODEL)),
        "w_ple_gate": nrm((L, D_MODEL, D_MODEL), D_MODEL),
        "w_ple_proj": nrm((L, PLE_DIM, D_MODEL), PLE_DIM),
        "final_norm": gain((D_MODEL,)),
    }


def reference(x, p, attn_norm, w_in, q_norm, w_uq, kv_norm, w_ukv, w_branch_a, w_branch_b, w_out,
              ffn_norm, w_router, b_router, w_gate, b_gate, w_up, b_up, w_down, b_down,
              ple_norm, w_ple_gate, w_ple_proj, final_norm):
    for i in range(DEPTH):
        h = rmsnorm(x, attn_norm[i])
        x = x + token_mixer(h, w_in[i], q_norm[i], w_uq[i], kv_norm[i], w_ukv[i],
                            w_branch_a[i], w_branch_b[i], w_out[i])
        h = rmsnorm(x, ffn_norm[i])
        x = x + moe_ffn(h, w_router[i], b_router[i], w_gate[i], b_gate[i], w_up[i], b_up[i],
                        w_down[i], b_down[i])
        ple_gate = jax.nn.sigmoid(rmsnorm(x, ple_norm[i]) @ w_ple_gate[i])
        x = x + ple_gate * (p[i] @ w_ple_proj[i])
    return rmsnorm(x, final_norm)
```

```cpp
#include <hip/hip_runtime.h>
#include <cstdio>
#include <cstdint>

#define GAS __attribute__((address_space(1)))
#define LAS __attribute__((address_space(3)))
typedef unsigned short bf16_t;
typedef short bf16x8 __attribute__((ext_vector_type(8)));
typedef short s16x4 __attribute__((ext_vector_type(4)));
typedef float f32x2 __attribute__((ext_vector_type(2)));
typedef float f32x4 __attribute__((ext_vector_type(4)));
typedef float f32x16 __attribute__((ext_vector_type(16)));
typedef unsigned u32x2 __attribute__((ext_vector_type(2)));
typedef unsigned u32x4 __attribute__((ext_vector_type(4)));
typedef __bf16 bf16x2_t __attribute__((ext_vector_type(2)));

constexpr int BATCH = 4, SEQ = 8192, T = BATCH * SEQ, DM = 1024, DEPTH = 2, PLE = 256;
constexpr int NE = 32, DE = 1024;
constexpr int IN_COLS = 5024, ZC = 5120;
constexpr int QLORA = 384, KVLORA = 256, NH = 8, DQK = 96, DNOPE = 64, DROPE = 32, DV = 64;
constexpr int ZM_LD = 768, ZD_LD = 2304, GT_LD = 2048, Q_LD = 768, KV_LD = 1024;
constexpr int RMAXB = 544, RMAX = RMAXB * 256;
constexpr float EPS = 1e-6f;
constexpr float LOG2E = 1.4426950408889634f;
constexpr float C2_MLA = 0.10206207261596577f * LOG2E;
constexpr float C2_DIL = 0.125f * LOG2E;
constexpr int NWAVES = 8, NTHR = 512;
#ifndef PHASE_MASK
#define PHASE_MASK 0xFFFFFFFFu
#endif
#define PH(k) ((PHASE_MASK >> (k)) & 1u)

constexpr size_t MiB = 1u << 20;
constexpr size_t al(size_t x) { return (x + 255) / 256 * 256; }
constexpr size_t WS_CTL = 0;
constexpr size_t WS_RSS = 1 * MiB;
constexpr size_t ZERO_BYTES = 1 * MiB;
constexpr size_t WS_ROPE = al(WS_RSS + (size_t)46 * T * 4);
constexpr size_t WS_WR = WS_ROPE + 2 * 8192 * 16 * 4;
constexpr size_t WS_WIN = WS_WR + 2 * 32768 * 4;
constexpr size_t WS_WUQ = WS_WIN + (size_t)2 * ZC * DM * 2;
constexpr size_t WS_WUKV = WS_WUQ + (size_t)2 * 768 * 384 * 2;
constexpr size_t WS_WA = WS_WUKV + (size_t)2 * 1024 * 256 * 2;
constexpr size_t WS_WB = WS_WA + (size_t)2 * 1024 * 512 * 2;
constexpr size_t WS_WO = WS_WB + (size_t)2 * 1024 * 256 * 2;
constexpr size_t WS_WPG = WS_WO + (size_t)2 * 1024 * 1024 * 2;
constexpr size_t WS_WPP = WS_WPG + (size_t)2 * 1024 * 1024 * 2;
constexpr size_t WS_WGU = WS_WPP + (size_t)2 * 1024 * 256 * 2;
constexpr size_t WS_WD = WS_WGU + (size_t)NE * 2048 * 1024 * 2;
constexpr size_t WS_XBA = WS_WD + (size_t)NE * 1024 * 1024 * 2;
constexpr size_t WS_XBB = WS_XBA + (size_t)T * DM * 2;
constexpr size_t WS_PB = WS_XBB + (size_t)T * DM * 2;
constexpr size_t WS_PP = WS_PB + (size_t)2 * T * PLE * 2;
constexpr size_t WS_ASG = WS_PP + (size_t)T * DM * 2;
constexpr size_t WS_TW = WS_ASG + (size_t)T * 4 * 4;
constexpr size_t WS_DST = WS_TW + (size_t)T * 4 * 4;
constexpr size_t WS_RROW = WS_DST + (size_t)T * 4 * 4;
constexpr size_t WS_RW = WS_RROW + (size_t)RMAX * 4;
constexpr size_t WS_U = al(WS_RW + (size_t)RMAX * 4);
constexpr size_t WS_ZM = WS_U;
constexpr size_t WS_ZD = WS_ZM + (size_t)T * ZM_LD * 2;
constexpr size_t WS_GT = WS_ZD + (size_t)T * ZD_LD * 2;
constexpr size_t WS_Q = WS_GT + (size_t)T * GT_LD * 2;
constexpr size_t WS_KV = WS_Q + (size_t)T * Q_LD * 2;
constexpr size_t WS_KR = WS_KV + (size_t)T * KV_LD * 2;
constexpr size_t WS_OA = WS_KR + (size_t)T * 32 * 2;
constexpr size_t WS_OG = WS_OA + (size_t)T * 512 * 2;
constexpr size_t WS_LSE = WS_OG + (size_t)3 * T * 256 * 2;
constexpr size_t WS_OB = WS_LSE + (size_t)3 * T * 4 * 4;
constexpr size_t WS_MIXER_END = WS_OB + (size_t)T * 256 * 2;
constexpr size_t WS_MIX = WS_ZD;
constexpr size_t WS_XG = WS_U;
constexpr size_t WS_HM = WS_XG + (size_t)RMAX * DM * 2;
constexpr size_t WS_MOE_END = WS_HM + (size_t)RMAX * DE * 2;
constexpr size_t WS_END = WS_MIXER_END > WS_MOE_END ? WS_MIXER_END : WS_MOE_END;
static_assert(WS_END <= (size_t)1024 * MiB, "workspace map must fit 1 GiB");
static_assert(WS_ZD + (size_t)T * DM * 2 <= WS_GT, "MIX overlay inside zd");

constexpr int CW_BAR = 4096;
constexpr int CW_CNT = 8192;
enum { RSP_ATTN = 0, RSP_FFN = 16, RSP_Q = 32, RSP_KV = 40, RS_FFNF = 44, RS_PLE = 45 };

constexpr int RING_BYTES = 131072;
constexpr int LDSCTL_OFF = RING_BYTES;
constexpr int LT_MISC = 0, LT_UCUM = 64, LT_RB0 = 128, LT_HIST = 192, LT_BASE = 256;
constexpr int LDS_BYTES = 147456;

#define LDS_WAIT() asm volatile("s_waitcnt lgkmcnt(0)" ::: "memory")
#define VM_WAIT() asm volatile("s_waitcnt vmcnt(0)" ::: "memory")
__device__ __forceinline__ unsigned cvtpk(float lo, float hi) { f32x2 v = {lo, hi}; bf16x2_t b = __builtin_convertvector(v, bf16x2_t); return __builtin_bit_cast(unsigned, b); }
__device__ __forceinline__ u32x4 pack8(f32x4 a, f32x4 b) { u32x4 w; w.x = cvtpk(a[0], a[1]); w.y = cvtpk(a[2], a[3]); w.z = cvtpk(b[0], b[1]); w.w = cvtpk(b[2], b[3]); return w; }
__device__ __forceinline__ float bflo(unsigned w) { return __uint_as_float(w << 16); }
__device__ __forceinline__ float bfhi(unsigned w) { return __uint_as_float(w & 0xffff0000u); }
__device__ __forceinline__ void unpack8(u32x4 w, f32x4& a, f32x4& b) { a = (f32x4){bflo(w.x), bfhi(w.x), bflo(w.y), bfhi(w.y)}; b = (f32x4){bflo(w.z), bfhi(w.z), bflo(w.w), bfhi(w.w)}; }
__device__ __forceinline__ float fsigmoid(float x) { return __builtin_amdgcn_rcpf(1.0f + __builtin_amdgcn_exp2f(-x * LOG2E)); }
__device__ __forceinline__ float wave_sum(float v) {
#pragma unroll
    for (int o = 1; o < 64; o <<= 1) v += __shfl_xor(v, o);
    return v;
}
__device__ __forceinline__ float sum4(const float* p) { const f32x4 a = *(const f32x4*)p; return (a[0] + a[1]) + (a[2] + a[3]); }
__device__ __forceinline__ float sum16(const float* p) { return (sum4(p) + sum4(p + 4)) + (sum4(p + 8) + sum4(p + 12)); }
__device__ __forceinline__ int crow(int r, int hi) { return (r & 3) + 8 * (r >> 2) + 4 * hi; }

#define XB_TMO      128
#define XB_XCNT(j)  (256  + 64 * (j))
#define XB_XSUB(j)  (1280 + 64 * (j))
#define XB_XGEN(j)  (2304 + 64 * (j))
#define XB_TOP      3328
#define XB_TOPGEN   3392
#define XCD_BAR_WORDS 3456
#define XB_SPIN_CAP (1u << 18)
__device__ __forceinline__ unsigned xb_ld(unsigned* p)              { return __hip_atomic_load(p, __ATOMIC_RELAXED, __HIP_MEMORY_SCOPE_AGENT); }
__device__ __forceinline__ unsigned xb_add(unsigned* p, unsigned v) { return __hip_atomic_fetch_add(p, v, __ATOMIC_RELAXED, __HIP_MEMORY_SCOPE_AGENT); }
__device__ __forceinline__ unsigned xb_xcc_id() { return (unsigned)__builtin_amdgcn_s_getreg((3 << 11) | 20) & 0xFu; }
#define XB_SPIN(cond, bar) do { unsigned _sp = 0; while (cond) { __builtin_amdgcn_s_sleep(1); \
    if ((++_sp & 255u) == 0u) { if (xb_ld(&(bar)[XB_TMO])) break; if (_sp > XB_SPIN_CAP) { atomicAdd(&(bar)[XB_TMO], 1u); break; } } } } while (0)
struct XcdBarrier { unsigned* bar; unsigned x; volatile LAS unsigned* st; };
__device__ __forceinline__ XcdBarrier xcd_barrier_post(unsigned* bar, volatile LAS unsigned* st) {
    XcdBarrier b; b.bar = bar; b.x = xb_xcc_id(); b.st = st;
    if (threadIdx.x == 0) (void)xb_add(&bar[XB_XCNT(b.x)], 1u);
    return b;
}
__device__ __forceinline__ void xcd_barrier_complete(unsigned* bar, unsigned x, unsigned& nloc, unsigned& nx) {
    const unsigned G = gridDim.x * gridDim.y * gridDim.z;
    unsigned sum, cnt, mine, sp = 0u;
    for (;;) {
        sum = 0u; cnt = 0u; mine = 0u;
#pragma unroll
        for (unsigned j = 0; j < 16; ++j) { const unsigned c = xb_ld(&bar[XB_XCNT(j)]); sum += c; cnt += (c > 0u) ? 1u : 0u; mine = (j == x) ? c : mine; }
        if (sum == G) break;
        __builtin_amdgcn_s_sleep(1);
        if ((++sp & 255u) == 0u) { if (xb_ld(&bar[XB_TMO])) break; if (sp > XB_SPIN_CAP) { atomicAdd(&bar[XB_TMO], 1u); break; } }
    }
    nloc = mine > 0u ? mine : 1u; nx = cnt > 0u ? cnt : 1u;
}
__device__ __forceinline__ void xcd_barrier(const XcdBarrier& b) {
    asm volatile("s_waitcnt vmcnt(0)" ::: "memory");
    __syncthreads();
    if (threadIdx.x == 0) {
        unsigned* bar = b.bar;
        __builtin_amdgcn_s_waitcnt(0);
        unsigned nloc = b.st[0], nx = b.st[1];
        if (nloc == 0u) { xcd_barrier_complete(bar, b.x, nloc, nx); b.st[0] = nloc; b.st[1] = nx; }
        const unsigned old = xb_add(&bar[XB_XSUB(b.x)], 1u);
        const unsigned gen = old / nloc;
        if (old + 1u == (gen + 1u) * nloc) {
            __builtin_amdgcn_fence(__ATOMIC_RELEASE, "agent");
            asm volatile("s_waitcnt vmcnt(0)" ::: "memory");
            const unsigned og = xb_add(&bar[XB_TOP], 1u);
            const unsigned tg = og / nx;
            if (og + 1u == (tg + 1u) * nx) xb_add(&bar[XB_TOPGEN], 1u);
            else XB_SPIN(xb_ld(&bar[XB_TOPGEN]) == tg, bar);
            __builtin_amdgcn_fence(__ATOMIC_ACQUIRE, "agent");
            xb_add(&bar[XB_XGEN(b.x)], 1u);
            asm volatile("s_waitcnt vmcnt(0)" ::: "memory");
        } else {
            XB_SPIN(xb_ld(&bar[XB_XGEN(b.x)]) == gen, bar);
            __builtin_amdgcn_fence(__ATOMIC_ACQUIRE, "agent");
            asm volatile("s_waitcnt vmcnt(0)" ::: "memory");
        }
    }
    __syncthreads();
}

namespace pg8 {
constexpr int BM = 256, BK = 64, HALF = 128, HTB = HALF * BK * 2, STAGE_BYTES = 8 * HTB, NXCD = 8, WGM = 8;
__host__ __device__ __forceinline__ int lds_byte(int r, int c) { const int st = (r >> 4) * 2 + (c >> 5), rr = r & 15, cc = c & 31, ob = rr * 64 + cc * 2; return st * 1024 + (ob ^ (((ob >> 9) & 1) << 5)); }
__host__ __device__ __forceinline__ void stage_rc(int b, int& R, int& C) { const int st = b / 1024, sb = b % 1024, swz = sb ^ (((sb >> 9) & 1) << 5); R = (st >> 1) * 16 + swz / 64; C = (st & 1) * 32 + (swz % 64) / 2; }
__host__ __device__ __forceinline__ int perm32(int rho) { const int n = rho >> 4, i = rho & 15; return 8 * (i >> 2) + 4 * n + (i & 3); }

struct Unit { const char* A; const char* B; int pm, pn, aux; };
struct Gemm { int lda, ldb, K; };

struct DenseSched {
    const char* A; const char* B; size_t tA, tB; int nM, nN, nwg, G, c;
    __device__ void init(const void* A_, int lda, const void* B_, int ldb, int M, int N, int G_, int c_) { A = (const char*)A_; B = (const char*)B_; tA = (size_t)BM * lda * 2; tB = (size_t)BM * ldb * 2; nM = M / BM; nN = N / BM; nwg = nM * nN; G = G_; c = c_; }
    __device__ bool next(int i, Unit& u) const {
        const long L = (long)i * G + c; if (L >= nwg) return false;
        int wgid = (int)L; { const int q = nwg / NXCD, r = nwg % NXCD, xcd = wgid % NXCD, off = wgid / NXCD; wgid = (xcd < r ? xcd * (q + 1) : r * (q + 1) + (xcd - r) * q) + off; }
        const int nig = WGM * nN, gid = wgid / nig, fm = gid * WGM, gsz = (nM - fm) < WGM ? (nM - fm) : WGM;
        u.pm = fm + ((wgid % nig) % gsz); u.pn = (wgid % nig) / gsz; u.aux = 0;
        u.A = A + (size_t)u.pm * tA; u.B = B + (size_t)u.pn * tB; return true;
    }
};
struct MoeSched {
    const char* A; const char* B; size_t tA, tB, eB; int NT, G, c; const LAS int* ucum; const LAS int* rb0;
    __device__ bool next(int i, Unit& u) const {
        const int nwg = __builtin_amdgcn_readfirstlane(ucum[NE]); const long L = (long)i * G + c; if (L >= nwg) return false;
        int wgid = (int)L; { const int q = nwg / NXCD, r = nwg % NXCD, xcd = wgid % NXCD, off = wgid / NXCD; wgid = (xcd < r ? xcd * (q + 1) : r * (q + 1) + (xcd - r) * q) + off; }
        int e = 0;
        for (int j = 1; j < NE; ++j) e = (wgid >= ucum[j]) ? j : e;
        e = __builtin_amdgcn_readfirstlane(e);
        const int local = wgid - __builtin_amdgcn_readfirstlane(ucum[e]); const int rb = local / NT, pn = local - rb * NT;
        u.pm = __builtin_amdgcn_readfirstlane(rb0[e]) + rb; u.pn = pn; u.aux = e;
        u.A = A + (size_t)u.pm * tA; u.B = B + (size_t)e * eB + (size_t)pn * tB; return true;
    }
};

template <class Epi, class Sched, bool ALIGN_EPI>
__device__ __forceinline__ void gemm_phase(LAS unsigned char* lds, const Gemm g, const Sched& S, const Epi& E, int wave_in) {
    int wid = wave_in; asm volatile("" : "+s"(wid)); int lane = (int)__builtin_amdgcn_mbcnt_hi(~0u, __builtin_amdgcn_mbcnt_lo(~0u, 0u)); asm volatile("" : "+v"(lane)); const int tid = wid * 64 + lane;
    const int wr = wid >> 2, wc = wid & 3, fr = lane & 15, fq = lane >> 4;
    const int K = g.K, nt = K / BK;
    unsigned voffA[2], voffB[2];
#pragma unroll
    for (int i = 0; i < 2; ++i) { int R, C; stage_rc(tid * 16 + i * 8192, R, C); const int Rb = (R & ~31) + perm32(R & 31);
        voffA[i] = (unsigned)(R * g.lda + C) * 2u; voffB[i] = (unsigned)(Rb * g.ldb + C) * 2u; }
    const size_t kstep = (size_t)(BK * 2);
    const size_t hA = (size_t)HALF * g.lda * 2, hB = (size_t)HALF * g.ldb * 2;
    const unsigned ldsw = (unsigned)wid * 1024u;
    const int aoff = lds_byte(wr * 64 + fr, fq * 8), boff = lds_byte(wc * 32 + fr, fq * 8);
#define PG8_SA(b, h) (((b) * 2 + (h)) * HTB)
#define PG8_SB(b, h) ((4 + (b) * 2 + (h)) * HTB)
#define PG8_STAGE(bufoff, gbase, voff) do { unsigned long long _gb = (unsigned long long)(gbase); asm volatile("" : "+s"(_gb)); _Pragma("unroll") for (int _i = 0; _i < 2; ++_i) \
        __builtin_amdgcn_global_load_lds((const GAS unsigned*)(_gb + (voff)[_i]), (LAS unsigned*)(lds + (bufoff) + ldsw + _i * 8192), 16, 0, 0); } while (0)
#define PG8_LDA(dst, b, h) do { _Pragma("unroll") for (int m = 0; m < 4; ++m) _Pragma("unroll") for (int k = 0; k < 2; ++k) dst[m][k] = *(const LAS bf16x8*)(lds + PG8_SA(b, h) + aoff + m * 2048 + k * 1024); } while (0)
#define PG8_LDB(dst, b, h) do { _Pragma("unroll") for (int n = 0; n < 2; ++n) _Pragma("unroll") for (int k = 0; k < 2; ++k) dst[n][k] = *(const LAS bf16x8*)(lds + PG8_SB(b, h) + boff + n * 2048 + k * 1024); } while (0)
#define PG8_MMA(ai, bj, At, Bt) do { __builtin_amdgcn_s_setprio(1); _Pragma("unroll") for (int m = 0; m < 4; ++m) _Pragma("unroll") for (int n = 0; n < 2; ++n) _Pragma("unroll") for (int k = 0; k < 2; ++k) \
        acc[ai][bj][m][n] = __builtin_amdgcn_mfma_f32_16x16x32_bf16(Bt[n][k], At[m][k], acc[ai][bj][m][n], 0, 0, 0); __builtin_amdgcn_s_setprio(0); } while (0)
#define PG8_WAIT_V(n) asm volatile("s_waitcnt vmcnt(" #n ")" ::: "memory")
#define PG8_WAIT_L(n) asm volatile("s_waitcnt lgkmcnt(" #n ")" ::: "memory")
#define PG8_BAR __builtin_amdgcn_s_barrier()
#define PG8_SCHED __builtin_amdgcn_sched_barrier(0)
    Unit cur, nxt; int ui = 0;
    if (!S.next(0, cur)) return;
    f32x4 acc[2][2][4][2];
#pragma unroll
    for (int a = 0; a < 2; ++a)
#pragma unroll
        for (int b = 0; b < 2; ++b)
#pragma unroll
            for (int m = 0; m < 4; ++m)
#pragma unroll
                for (int n = 0; n < 2; ++n) acc[a][b][m][n] = (f32x4){0.f, 0.f, 0.f, 0.f};
    bf16x8 At[4][2], B0[2][2], B1[2][2];
    const char* cA = cur.A; const char* cB = cur.B;
    PG8_STAGE(PG8_SB(0, 0), cB, voffB); PG8_STAGE(PG8_SB(0, 1), cB + hB, voffB); PG8_STAGE(PG8_SA(0, 0), cA, voffA); PG8_STAGE(PG8_SA(0, 1), cA + hA, voffA);
    if (wr == 1) PG8_BAR;
    PG8_WAIT_V(2); PG8_BAR;
    PG8_STAGE(PG8_SB(1, 0), cB + kstep, voffB); PG8_STAGE(PG8_SA(1, 0), cA + kstep, voffA); PG8_STAGE(PG8_SB(1, 1), cB + hB + kstep, voffB);
    PG8_WAIT_V(6); PG8_BAR;
    for (;;) {
        const bool has_next = S.next(ui + 1, nxt);
        const char* nA = has_next ? nxt.A : cA; const char* nB = has_next ? nxt.B : cB;
        for (int t = 0; t < nt; t += 2) {
            const bool last = (t == nt - 2);
            const char* a1 = cA + (size_t)(t + 1) * kstep;
            const char* a2 = last ? nA : cA + (size_t)(t + 2) * kstep; const char* b2 = last ? nB : cB + (size_t)(t + 2) * kstep;
            const char* a3 = a2 + kstep; const char* b3 = b2 + kstep;
            PG8_LDB(B0, 0, 0); PG8_LDB(B1, 0, 1); PG8_SCHED; PG8_LDA(At, 0, 0); PG8_STAGE(PG8_SA(1, 1), a1 + hA, voffA);
            PG8_WAIT_V(8); PG8_WAIT_L(0); PG8_BAR; PG8_MMA(0, 0, At, B0); PG8_MMA(0, 1, At, B1); PG8_BAR; PG8_SCHED;
            PG8_LDA(At, 0, 1); PG8_STAGE(PG8_SB(0, 0), b2, voffB); PG8_STAGE(PG8_SB(0, 1), b2 + hB, voffB); PG8_STAGE(PG8_SA(0, 0), a2, voffA);
            PG8_WAIT_V(8); PG8_WAIT_L(0); PG8_BAR; PG8_MMA(1, 0, At, B0); PG8_MMA(1, 1, At, B1); PG8_BAR; PG8_SCHED;
            PG8_LDB(B0, 1, 0); PG8_LDB(B1, 1, 1); PG8_SCHED; PG8_LDA(At, 1, 0); PG8_STAGE(PG8_SA(0, 1), a2 + hA, voffA);
            PG8_WAIT_V(8); PG8_WAIT_L(0); PG8_BAR; PG8_MMA(0, 0, At, B0); PG8_MMA(0, 1, At, B1); PG8_BAR; PG8_SCHED;
            PG8_LDA(At, 1, 1); PG8_STAGE(PG8_SB(1, 0), b3, voffB); PG8_STAGE(PG8_SB(1, 1), b3 + hB, voffB); PG8_STAGE(PG8_SA(1, 0), a3, voffA);
            PG8_WAIT_V(8); PG8_WAIT_L(0); PG8_BAR; PG8_MMA(1, 0, At, B0); PG8_MMA(1, 1, At, B1); PG8_BAR; PG8_SCHED;
        }
        if constexpr (ALIGN_EPI) { if (wr == 0) PG8_BAR; }
        { int fr_ = fr, fq_ = fq, wr_ = wr, wc_ = wc; asm volatile("" : "+v"(fr_), "+v"(fq_), "+s"(wr_), "+s"(wc_)); E(acc, cur, wr_, wc_, fr_, fq_); }
        if (!has_next) break;
#pragma unroll
        for (int a = 0; a < 2; ++a)
#pragma unroll
            for (int b = 0; b < 2; ++b)
#pragma unroll
                for (int m = 0; m < 4; ++m)
#pragma unroll
                    for (int n = 0; n < 2; ++n) acc[a][b][m][n] = (f32x4){0.f, 0.f, 0.f, 0.f};
        cur = nxt; cA = nA; cB = nB; ++ui;
        if constexpr (ALIGN_EPI) { if (wr == 1) PG8_BAR; }
    }
    PG8_WAIT_V(0);
    if constexpr (!ALIGN_EPI) { if (wr == 0) PG8_BAR; }
    PG8_BAR;
#undef PG8_SA
#undef PG8_SB
#undef PG8_STAGE
#undef PG8_LDA
#undef PG8_LDB
#undef PG8_MMA
#undef PG8_WAIT_V
#undef PG8_WAIT_L
#undef PG8_BAR
#undef PG8_SCHED
}

#define EPI_ROW(u, ai, m) ((u).pm * 256 + (ai) * 128 + wr * 64 + (m) * 16 + fr)
#define EPI_COL(bj) ((bj) * 128 + wc * 32 + 8 * fq)
typedef f32x4 Acc[2][2][4][2];
#define EPI_FENCE() asm volatile("" ::: "memory")

struct EpiZ {
    const float* rsp; float* rspq; float* rspkv; bf16_t* zm; bf16_t* zd; bf16_t* gt; bf16_t* kr; const float* cosT; const float* sinT;
    __device__ __forceinline__ void operator()(const Acc& acc, const Unit& u, int wr, int wc, int fr, int fq) const {
        const int pn = u.pn;
#pragma unroll
        for (int ai = 0; ai < 2; ++ai)
#pragma unroll
            for (int m = 0; m < 4; ++m) {
                const int row = EPI_ROW(u, ai, m);
                const float rstd = __builtin_amdgcn_rsqf(sum16(rsp + (size_t)row * 16) * (1.0f / DM) + EPS);
                if (pn < 3) {
                    float ss = 0.f;
#pragma unroll
                    for (int bj = 0; bj < 2; ++bj) {
                        const f32x4 v0 = acc[ai][bj][m][0] * rstd, v1 = acc[ai][bj][m][1] * rstd;
                        *(u32x4*)(zm + (size_t)row * ZM_LD + pn * 256 + EPI_COL(bj)) = pack8(v0, v1);
                        if (pn != 2 || bj == 0) ss += (v0[0] * v0[0] + v0[1] * v0[1]) + (v0[2] * v0[2] + v0[3] * v0[3]) + (v1[0] * v1[0] + v1[1] * v1[1]) + (v1[2] * v1[2] + v1[3] * v1[3]);
                        if (pn == 2 && bj == 1 && wc == 0) {
                            const int pos = row & (SEQ - 1);
                            const f32x4 cs = *(const f32x4*)(cosT + pos * 16 + 4 * fq), sn = *(const f32x4*)(sinT + pos * 16 + 4 * fq);
                            const f32x4 o0 = v0 * cs - v1 * sn, o1 = v0 * sn + v1 * cs;
                            *(u32x4*)(kr + (size_t)row * 32 + 8 * fq) = pack8(o0, o1);
                        }
                    }
                    ss += __shfl_xor(ss, 16); ss += __shfl_xor(ss, 32);
                    if (fq == 0) { if (pn == 0) rspkv[(size_t)row * 4 + wc] = ss; else rspq[(size_t)row * 8 + (pn - 1) * 4 + wc] = ss; }
                } else if (pn < 12) {
                    const int j = pn - 3; const float sc = rstd * ((j % 3) == 0 ? C2_DIL : 1.0f);
#pragma unroll
                    for (int bj = 0; bj < 2; ++bj) *(u32x4*)(zd + (size_t)row * ZD_LD + j * 256 + EPI_COL(bj)) = pack8(acc[ai][bj][m][0] * sc, acc[ai][bj][m][1] * sc);
                } else {
                    const int j = pn - 12;
#pragma unroll
                    for (int bj = 0; bj < 2; ++bj) { f32x4 v0 = acc[ai][bj][m][0] * rstd, v1 = acc[ai][bj][m][1] * rstd;
#pragma unroll
                        for (int i = 0; i < 4; ++i) { v0[i] = fsigmoid(v0[i]); v1[i] = fsigmoid(v1[i]); }
                        *(u32x4*)(gt + (size_t)row * GT_LD + j * 256 + EPI_COL(bj)) = pack8(v0, v1); }
                }
                EPI_FENCE();
            }
    }
};
struct EpiGen {
    bf16_t* out; int ldo; const float* rs; int rsn; float rsdiv; float cscale; const bf16_t* mul; int ldm; const bf16_t* add; int ldadd;
    __device__ __forceinline__ void operator()(const Acc& acc, const Unit& u, int wr, int wc, int fr, int fq) const {
#pragma unroll
        for (int ai = 0; ai < 2; ++ai)
#pragma unroll
            for (int m = 0; m < 4; ++m) {
                const int row = EPI_ROW(u, ai, m);
                float sc = 1.0f; if (rs) { float t = sum4(rs + (size_t)row * 4 * rsn); if (rsn == 2) t += sum4(rs + (size_t)row * 8 + 4); sc = __builtin_amdgcn_rsqf(t * rsdiv + EPS) * cscale; }
#pragma unroll
                for (int bj = 0; bj < 2; ++bj) {
                    const int col = u.pn * 256 + EPI_COL(bj);
                    f32x4 v0 = acc[ai][bj][m][0] * sc, v1 = acc[ai][bj][m][1] * sc;
                    if (mul) { f32x4 g0, g1; unpack8(*(const u32x4*)(mul + (size_t)row * ldm + col), g0, g1); v0 = v0 * g0; v1 = v1 * g1; }
                    if (add) { f32x4 a0, a1; unpack8(*(const u32x4*)(add + (size_t)row * ldadd + col), a0, a1); v0 = v0 + a0; v1 = v1 + a1; }
                    *(u32x4*)(out + (size_t)row * ldo + col) = pack8(v0, v1);
                }
                EPI_FENCE();
            }
    }
};
template <bool GATED> struct EpiRes {
    const float* xin; float* xout; bf16_t* xb; float* rspn; const float* rs; const bf16_t* pp;
    __device__ __forceinline__ void operator()(const Acc& acc, const Unit& u, int wr, int wc, int fr, int fq) const {
#pragma unroll
        for (int ai = 0; ai < 2; ++ai)
#pragma unroll
            for (int m = 0; m < 4; ++m) {
                const int row = EPI_ROW(u, ai, m);
                float sc = 1.0f; if (GATED) sc = __builtin_amdgcn_rsqf(rs[row] * (1.0f / DM) + EPS);
                float ss = 0.f;
#pragma unroll
                for (int bj = 0; bj < 2; ++bj) {
                    const size_t o = (size_t)row * DM + u.pn * 256 + EPI_COL(bj);
                    f32x4 v0 = acc[ai][bj][m][0], v1 = acc[ai][bj][m][1];
                    if (GATED) { f32x4 p0, p1; unpack8(*(const u32x4*)(pp + o), p0, p1);
#pragma unroll
                        for (int i = 0; i < 4; ++i) { v0[i] = fsigmoid(v0[i] * sc) * p0[i]; v1[i] = fsigmoid(v1[i] * sc) * p1[i]; } }
                    v0 = v0 + *(const f32x4*)(xin + o); v1 = v1 + *(const f32x4*)(xin + o + 4);
                    *(f32x4*)(xout + o) = v0; *(f32x4*)(xout + o + 4) = v1;
                    *(u32x4*)(xb + o) = pack8(v0, v1);
                    ss += (v0[0] * v0[0] + v0[1] * v0[1]) + (v0[2] * v0[2] + v0[3] * v0[3]) + (v1[0] * v1[0] + v1[1] * v1[1]) + (v1[2] * v1[2] + v1[3] * v1[3]);
                }
                ss += __shfl_xor(ss, 16); ss += __shfl_xor(ss, 32);
                if (fq == 0) rspn[(size_t)row * 16 + u.pn * 4 + wc] = ss;
                EPI_FENCE();
            }
    }
};
struct EpiSwiglu {
    bf16_t* hm; const float* rrow; const float* bg; const float* bu;
    __device__ __forceinline__ void operator()(const Acc& acc, const Unit& u, int wr, int wc, int fr, int fq) const {
        const int hc = u.pn * 128 + wc * 32 + 8 * fq;
        const f32x4 bg0 = *(const f32x4*)(bg + u.aux * DE + hc), bg1 = *(const f32x4*)(bg + u.aux * DE + hc + 4);
        const f32x4 bu0 = *(const f32x4*)(bu + u.aux * DE + hc), bu1 = *(const f32x4*)(bu + u.aux * DE + hc + 4);
#pragma unroll
        for (int ai = 0; ai < 2; ++ai)
#pragma unroll
            for (int m = 0; m < 4; ++m) {
                const int row = EPI_ROW(u, ai, m);
                const float sc = rrow[row];
                f32x4 g0 = acc[ai][0][m][0] * sc + bg0, g1 = acc[ai][0][m][1] * sc + bg1, u0 = acc[ai][1][m][0] * sc + bu0, u1 = acc[ai][1][m][1] * sc + bu1;
#pragma unroll
                for (int i = 0; i < 4; ++i) {
                    const float a0 = fminf(g0[i], 7.0f), a1 = fminf(g1[i], 7.0f);
                    const float c0 = fminf(fmaxf(u0[i], -7.0f), 7.0f), c1 = fminf(fmaxf(u1[i], -7.0f), 7.0f);
                    g0[i] = a0 * fsigmoid(1.702f * a0) * (c0 + 1.0f); g1[i] = a1 * fsigmoid(1.702f * a1) * (c1 + 1.0f);
                }
                *(u32x4*)(hm + (size_t)row * DE + hc) = pack8(g0, g1);
                EPI_FENCE();
            }
    }
};
struct EpiDown {
    bf16_t* y; const float* rw; const float* bd;
    __device__ __forceinline__ void operator()(const Acc& acc, const Unit& u, int wr, int wc, int fr, int fq) const {
#pragma unroll
        for (int ai = 0; ai < 2; ++ai)
#pragma unroll
            for (int m = 0; m < 4; ++m) {
                const int row = EPI_ROW(u, ai, m);
                const float w = rw[row];
#pragma unroll
                for (int bj = 0; bj < 2; ++bj) {
                    const int col = u.pn * 256 + EPI_COL(bj);
                    const f32x4 b0 = *(const f32x4*)(bd + u.aux * DM + col), b1 = *(const f32x4*)(bd + u.aux * DM + col + 4);
                    *(u32x4*)(y + (size_t)row * DM + col) = pack8((acc[ai][bj][m][0] + b0) * w, (acc[ai][bj][m][1] + b1) * w);
                }
                EPI_FENCE();
            }
    }
};
}

namespace att {
constexpr int KVBLK = 64;
constexpr int SHM_K = 64 * 256, SHM_V = 64 * 64 * 2;
constexpr int OFF_K = 0, OFF_V = 2 * SHM_K, OFF_WS = 2 * SHM_K + 2 * SHM_V, ATT_LDS = OFF_WS + 8 * 256;
constexpr float THR = 8.0f;
#define KSWZ(row, colB) ((row) * 256 + ((colB) ^ (((row) & 7) << 4)))
#define SBAR() __builtin_amdgcn_sched_barrier(0)
__device__ __forceinline__ int v_st(int k, int c) { const int kk = (k & ~0xC) | ((k & 4) << 1) | ((k & 8) >> 1); return ((kk >> 3) * 2 + (c >> 5)) * 512 + ((kk & 7) * 32 + (c & 31)) * 2; }
__device__ __forceinline__ int v_rd_base(int lane) { return ((lane & 3) << 3) | (((lane >> 2) & 3) << 6) | (((lane >> 4) & 1) << 5) | (((lane >> 5) & 1) << 8); }
constexpr int v_rd_off(int d0, int ks, int half) { return d0 * 512 + ks * 2048 + half * 1024; }
template <int OFF> __device__ __forceinline__ s16x4 tr_read(int vb) { s16x4 r; asm volatile("ds_read_b64_tr_b16 %0, %1 offset:%2" : "=&v"(r) : "v"(vb), "i"(OFF) : "memory"); return r; }
template <int D0> __device__ __forceinline__ void pv_one(f32x16& od, int vb, bf16x8 pa0, bf16x8 pa1, bf16x8 pa2, bf16x8 pa3) {
    const s16x4 l0 = tr_read<v_rd_off(D0, 0, 0)>(vb), h0 = tr_read<v_rd_off(D0, 0, 1)>(vb), l1 = tr_read<v_rd_off(D0, 1, 0)>(vb), h1 = tr_read<v_rd_off(D0, 1, 1)>(vb);
    const s16x4 l2 = tr_read<v_rd_off(D0, 2, 0)>(vb), h2 = tr_read<v_rd_off(D0, 2, 1)>(vb), l3 = tr_read<v_rd_off(D0, 3, 0)>(vb), h3 = tr_read<v_rd_off(D0, 3, 1)>(vb);
    asm volatile("s_waitcnt lgkmcnt(0)" ::: "memory"); SBAR();
#define PK(L, H) (bf16x8){L[0], L[1], L[2], L[3], H[0], H[1], H[2], H[3]}
    od = __builtin_amdgcn_mfma_f32_32x32x16_bf16(pa0, PK(l0, h0), od, 0, 0, 0);
    od = __builtin_amdgcn_mfma_f32_32x32x16_bf16(pa1, PK(l1, h1), od, 0, 0, 0);
    od = __builtin_amdgcn_mfma_f32_32x32x16_bf16(pa2, PK(l2, h2), od, 0, 0, 0);
    od = __builtin_amdgcn_mfma_f32_32x32x16_bf16(pa3, PK(l3, h3), od, 0, 0, 0);
#undef PK
}
__device__ __forceinline__ void pv_d0(f32x16* o, int vb, bf16x8 pa0, bf16x8 pa1, bf16x8 pa2, bf16x8 pa3) { pv_one<0>(o[0], vb, pa0, pa1, pa2, pa3); pv_one<1>(o[1], vb, pa0, pa1, pa2, pa3); }
__device__ __forceinline__ void partialSM(f32x16& p0, f32x16& p1, float& m_reg, float& alpha) {
    float pmax = p0[0];
#pragma unroll
    for (int r = 1; r < 16; ++r) pmax = fmaxf(pmax, p0[r]);
#pragma unroll
    for (int r = 0; r < 16; ++r) pmax = fmaxf(pmax, p1[r]);
    { auto rr = __builtin_amdgcn_permlane32_swap(__float_as_uint(pmax), __float_as_uint(pmax), false, false); pmax = fmaxf(__uint_as_float(rr[0]), __uint_as_float(rr[1])); }
    float mn;
    if (__builtin_expect(__all(pmax - m_reg <= THR), 1)) { mn = m_reg; alpha = 1.f; }
    else { mn = fmaxf(m_reg, pmax); alpha = __builtin_amdgcn_exp2f(m_reg - mn); m_reg = mn; }
#pragma unroll
    for (int r = 0; r < 16; ++r) { p0[r] = p0[r] - mn; p1[r] = p1[r] - mn; }
#pragma unroll
    for (int r = 0; r < 16; ++r) p0[r] = __builtin_amdgcn_exp2f(p0[r]);
}
__device__ __forceinline__ void finishSM(f32x16& p0, f32x16& p1, float alpha, float& l_reg, bf16x8& pa0, bf16x8& pa1, bf16x8& pa2, bf16x8& pa3) {
#pragma unroll
    for (int r = 0; r < 16; ++r) p1[r] = __builtin_amdgcn_exp2f(p1[r]);
    float ps = 0;
#pragma unroll
    for (int r = 0; r < 16; ++r) ps += p0[r];
#pragma unroll
    for (int r = 0; r < 16; ++r) ps += p1[r];
    { auto rr = __builtin_amdgcn_permlane32_swap(__float_as_uint(ps), __float_as_uint(ps), false, false); ps = __uint_as_float(rr[0]) + __uint_as_float(rr[1]); }
    l_reg = l_reg * alpha + ps;
#define PK4(P, BASE, OUT) do { unsigned a0 = cvtpk(P[BASE + 0], P[BASE + 1]), a1 = cvtpk(P[BASE + 2], P[BASE + 3]);   \
    unsigned b0 = cvtpk(P[BASE + 4], P[BASE + 5]), b1 = cvtpk(P[BASE + 6], P[BASE + 7]);                              \
    auto r0 = __builtin_amdgcn_permlane32_swap(a0, b0, false, false); auto r1 = __builtin_amdgcn_permlane32_swap(a1, b1, false, false); \
    u32x4 w = {r0[0], r1[0], r0[1], r1[1]}; OUT = __builtin_bit_cast(bf16x8, w); } while (0)
    PK4(p0, 0, pa0); PK4(p0, 8, pa1); PK4(p1, 0, pa2); PK4(p1, 8, pa3);
#undef PK4
}
template <int NQ> __device__ __forceinline__ void qkt(f32x16& p0, f32x16& p1, const LAS char* Ks, const bf16x8* qr, int r32, int hi) {
    p0 = f32x16{}; p1 = f32x16{};
#pragma unroll
    for (int d0 = 0; d0 < NQ; ++d0) { const int cb = (d0 * 16 + hi * 8) * 2;
        const bf16x8 b0 = *(const LAS bf16x8*)(Ks + KSWZ(r32, cb));
        const bf16x8 b1 = *(const LAS bf16x8*)(Ks + KSWZ(32 + r32, cb));
        p0 = __builtin_amdgcn_mfma_f32_32x32x16_bf16(b0, qr[d0], p0, 0, 0, 0);
        p1 = __builtin_amdgcn_mfma_f32_32x32x16_bf16(b1, qr[d0], p1, 0, 0, 0); }
}
struct Args {
    const bf16_t* Q; long ldq;
    const bf16_t* K; long ldk;
    const bf16_t* K2; long ldk2;
    const bf16_t* V; long ldv;
    bf16_t* O; long ldo; float* lse; long ldlse;
    const float* cosT; const float* sinT;
    int t0, t1;
    int qoff;
    int tmask;
    float ab;
};
template <int MODE> __device__ __forceinline__ void mask_tile(f32x16& p0, f32x16& p1, int t, int n, int hi, const Args& a) {
    const int base = n + a.qoff - 64 * t - 4 * hi;
    if (MODE == 0) { if (t < a.tmask) return;
#pragma unroll
        for (int r = 0; r < 16; ++r) { const int rel = base - ((r & 3) + 8 * (r >> 2)); if (rel < 0) p0[r] = -INFINITY; if (rel - 32 < 0) p1[r] = -INFINITY; }
    } else {
#pragma unroll
        for (int r = 0; r < 16; ++r) { const int rel = base - ((r & 3) + 8 * (r >> 2)); const int rel1 = rel - 32;
            p0[r] = (rel < 0 || rel > 128) ? -INFINITY : p0[r] - a.ab * (float)rel;
            p1[r] = (rel1 < 0 || rel1 > 128) ? -INFINITY : p1[r] - a.ab * (float)rel1; }
    }
}
template <int MODE> __device__ __forceinline__ void attn_unit(const Args& a, LAS char* lds, int wave_in) {
    constexpr int NQ = MODE == 0 ? 6 : 4;
    int wid = wave_in; asm volatile("" : "+s"(wid)); int lane = (int)__builtin_amdgcn_mbcnt_hi(~0u, __builtin_amdgcn_mbcnt_lo(~0u, 0u)); asm volatile("" : "+v"(lane)); const int tid = wid * 64 + lane;
    const int r32 = lane & 31, hi = lane >> 5;
    LAS char* V_lds = lds + OFF_V; LAS char* K_lds = lds + OFF_K;
    LAS float* ws = (LAS float*)(lds + OFF_WS) + wid * 64; LAS float* li_l = ws; LAS float* al_l = ws + 32;
    float m_reg = -1e30f, l_reg = 0; f32x16 o[2] = {}; bf16x8 qr[NQ];
    const bf16_t* Qw = a.Q + (long)(wid * 32 + r32) * a.ldq + hi * 8;
#pragma unroll
    for (int d0 = 0; d0 < NQ; ++d0) qr[d0] = *(const bf16x8*)(Qw + d0 * 16);
    if (MODE == 0) {
        const int pos = a.qoff + wid * 32 + r32;
#pragma unroll
        for (int d0 = 4; d0 < 6; ++d0) { const int jg = 2 * (d0 - 4) + hi;
            const f32x4 cs = *(const f32x4*)(a.cosT + pos * 16 + 4 * jg), sn = *(const f32x4*)(a.sinT + pos * 16 + 4 * jg);
            f32x4 v0, v1; unpack8(__builtin_bit_cast(u32x4, qr[d0 < NQ ? d0 : 0]), v0, v1);
            const f32x4 o0 = v0 * cs - v1 * sn, o1 = v0 * sn + v1 * cs;
            if (d0 < NQ) qr[d0] = __builtin_bit_cast(bf16x8, pack8(o0, o1)); }
    }
    const int sr = tid >> 4, kc = tid & 15, vr = tid >> 3, vc = tid & 7;
    const int vst = v_st(vr, vc * 8);
    const int vb0 = (int)(uintptr_t)V_lds + v_rd_base(lane);
    const bf16_t* kp0; const bf16_t* kp1; long kstep64; int kst0, kst1;
    if (MODE == 0) { const bool rope = kc >= 8; const int kcc = rope ? ((kc - 8) & 3) : kc;
        kp0 = rope ? a.K2 + (long)sr * a.ldk2 + kcc * 8 : a.K + (long)sr * a.ldk + kcc * 8;
        kp1 = rope ? a.K2 + (long)(sr + 32) * a.ldk2 + kcc * 8 : a.K + (long)(sr + 32) * a.ldk + kcc * 8;
        kstep64 = rope ? 64 * a.ldk2 : 64 * a.ldk; kst0 = KSWZ(sr, kc * 16); kst1 = KSWZ(sr + 32, kc * 16);
    } else { kp0 = a.K + (long)vr * a.ldk + vc * 8; kp1 = kp0; kstep64 = 64 * a.ldk; kst0 = KSWZ(vr, vc * 16); kst1 = kst0; }
    const bf16_t* vp = a.V + (long)vr * a.ldv + vc * 8; const long vstep64 = 64 * a.ldv;
    struct Slot { bf16x8 v, k0, k1; } sl[1];
#define SLOAD(i, t) do { sl[i].v = *(const bf16x8*)(vp + (long)(t) * vstep64); sl[i].k0 = *(const bf16x8*)(kp0 + (long)(t) * kstep64); \
        if (MODE == 0) sl[i].k1 = *(const bf16x8*)(kp1 + (long)(t) * kstep64); } while (0)
#define SWRITE(b, i) do { *(LAS bf16x8*)(V_lds + (b) * SHM_V + vst) = sl[i].v; *(LAS bf16x8*)(K_lds + (b) * SHM_K + kst0) = sl[i].k0; \
        if (MODE == 0) *(LAS bf16x8*)(K_lds + (b) * SHM_K + kst1) = sl[i].k1; } while (0)
#define SWAIT() asm volatile("s_waitcnt vmcnt(0)" ::: "memory")
#define RESC(al) do { if (__any((al) < 1.f)) { if (hi == 0) al_l[r32] = (al); asm volatile("s_waitcnt lgkmcnt(0)" ::: "memory"); \
        _Pragma("unroll") for (int d = 0; d < 2; ++d) _Pragma("unroll") for (int r = 0; r < 16; ++r) o[d][r] *= al_l[crow(r, hi)]; } } while (0)
    f32x16 pA0, pA1, pB0, pB1; float alA, alB; bf16x8 pa0, pa1, pa2, pa3;
    const int N = a.t1 - a.t0, T0 = a.t0, n = wid * 32 + r32;
    SLOAD(0, T0); asm volatile("s_waitcnt vmcnt(0)" ::: "memory"); SWRITE(0, 0); __syncthreads();
    qkt<NQ>(pA0, pA1, K_lds, qr, r32, hi); mask_tile<MODE>(pA0, pA1, T0, n, hi, a); partialSM(pA0, pA1, m_reg, alA);
    SLOAD(0, T0 + 1);
    SWAIT(); SWRITE(1, 0); __syncthreads();
    for (int j = 1; j + 1 < N; j += 2) {
        SBAR(); qkt<NQ>(pB0, pB1, K_lds + SHM_K, qr, r32, hi); mask_tile<MODE>(pB0, pB1, T0 + j, n, hi, a);
        finishSM(pA0, pA1, alA, l_reg, pa0, pa1, pa2, pa3); SBAR();
        SLOAD(0, T0 + j + 1); SBAR();
        pv_d0(o, vb0, pa0, pa1, pa2, pa3); partialSM(pB0, pB1, m_reg, alB);
        __syncthreads(); SWAIT(); SWRITE(0, 0);
        RESC(alB); __syncthreads();
        SBAR(); qkt<NQ>(pA0, pA1, K_lds, qr, r32, hi); mask_tile<MODE>(pA0, pA1, T0 + j + 1, n, hi, a);
        finishSM(pB0, pB1, alB, l_reg, pa0, pa1, pa2, pa3); SBAR();
        SLOAD(0, T0 + j + 2); SBAR();
        pv_d0(o, vb0 + SHM_V, pa0, pa1, pa2, pa3); partialSM(pA0, pA1, m_reg, alA);
        __syncthreads(); SWAIT(); SWRITE(1, 0);
        RESC(alA); __syncthreads();
    }
    SBAR(); qkt<NQ>(pB0, pB1, K_lds + SHM_K, qr, r32, hi); mask_tile<MODE>(pB0, pB1, T0 + N - 1, n, hi, a);
    finishSM(pA0, pA1, alA, l_reg, pa0, pa1, pa2, pa3); SBAR();
    pv_d0(o, vb0, pa0, pa1, pa2, pa3); partialSM(pB0, pB1, m_reg, alB);
    __syncthreads(); RESC(alB);
    finishSM(pB0, pB1, alB, l_reg, pa0, pa1, pa2, pa3); SBAR();
    pv_d0(o, vb0 + SHM_V, pa0, pa1, pa2, pa3);
    if (hi == 0) li_l[r32] = l_reg; asm volatile("s_waitcnt lgkmcnt(0)" ::: "memory");
    float rli[16];
#pragma unroll
    for (int r = 0; r < 16; ++r) rli[r] = __builtin_amdgcn_rcpf(li_l[crow(r, hi)]);
    bf16_t* Ow = a.O + (long)(wid * 32) * a.ldo;
#pragma unroll
    for (int r = 0; r < 16; ++r) { const int orow = crow(r, hi);
#pragma unroll
        for (int d0 = 0; d0 < 2; ++d0) Ow[(long)orow * a.ldo + d0 * 32 + r32] = (bf16_t)(cvtpk(o[d0][r] * rli[r], 0.f) & 0xffffu); }
    if (MODE == 1) { if (hi == 0) a.lse[(long)n * a.ldlse] = (m_reg + __builtin_amdgcn_logf(l_reg)) * 0.6931471805599453f; }
    __syncthreads();
#undef SLOAD
#undef SWRITE
#undef SWAIT
#undef RESC
}
#undef KSWZ
#undef SBAR
}

struct KArgs { const float* in[24]; float* out; unsigned char* ws; };
enum { I_X = 0, I_P, I_ATTN_NORM, I_W_IN, I_Q_NORM, I_W_UQ, I_KV_NORM, I_W_UKV, I_W_A, I_W_B, I_W_OUT, I_FFN_NORM, I_W_ROUTER, I_B_ROUTER,
       I_W_GATE, I_B_GATE, I_W_UP, I_B_UP, I_W_DOWN, I_B_DOWN, I_PLE_NORM, I_W_PG, I_W_PP, I_FINAL_NORM };

__device__ __forceinline__ void tr_item(const float* W, int Nsrc, int sc  , const float* gain, bf16_t* WT, int K, int k0, int n0, LAS float* scr, int lane) {
#pragma unroll 8
    for (int i = 0; i < 32; ++i) { const int kk = 2 * i + (lane >> 5);
        float v = 0.f; if (sc >= 0) { v = W[(size_t)(k0 + kk) * Nsrc + sc]; if (gain) v *= gain[k0 + kk]; }
        scr[kk * 33 + (lane & 31)] = v; }
    LDS_WAIT(); asm volatile("" ::: "memory");
    const int c = lane & 7;
#pragma unroll
    for (int j = 0; j < 4; ++j) { const int n = (lane >> 3) + 8 * j; const LAS float* s = scr + (8 * c) * 33 + n;
        u32x4 o; o.x = cvtpk(s[0 * 33], s[1 * 33]); o.y = cvtpk(s[2 * 33], s[3 * 33]); o.z = cvtpk(s[4 * 33], s[5 * 33]); o.w = cvtpk(s[6 * 33], s[7 * 33]);
        *(u32x4*)(WT + (size_t)(n0 + n) * K + k0 + 8 * c) = o; }
    LDS_WAIT(); asm volatile("" ::: "memory");
}
__device__ __forceinline__ int rope_perm(int p) { const int j = p >> 3, i = p & 7; return (i < 4) ? 4 * j + i : 16 + 4 * j + (i - 4); }
__device__ __forceinline__ void convert_small(const KArgs& a, unsigned char* ws, int layer, LAS float* scr, int gw, int NGW, int lane) {
    constexpr int I_IN = 16 * 160, I_UQ = 6 * 24, I_UKV = 4 * 32, I_A = 8 * 32, I_B = 4 * 32, I_O = 16 * 32, I_PG = 16 * 32, I_PP = 4 * 32;
    constexpr int NIT = I_IN + I_UQ + I_UKV + I_A + I_B + I_O + I_PG + I_PP;
    const int l31 = lane & 31;
    for (int it = gw; it < NIT; it += NGW) {
        int r = it;
        if (r < I_IN) { const int kb = r / 160, nb = r % 160, n = nb * 32 + l31; int sc;
            if (n < 256) sc = 384 + n; else if (n < 640) sc = n - 256; else if (n < 672) sc = 640 + rope_perm(n - 640); else if (n < 768) sc = -1; else if (n < 3072) sc = 672 + (n - 768); else sc = 2976 + (n - 3072);
            tr_item(a.in[I_W_IN] + (size_t)layer * DM * IN_COLS, IN_COLS, sc, a.in[I_ATTN_NORM] + layer * DM, (bf16_t*)(ws + WS_WIN) + (size_t)layer * ZC * DM, DM, kb * 64, nb * 32, scr, lane); continue; } r -= I_IN;
        if (r < I_UQ) { const int kb = r / 24, nb = r % 24, n = nb * 32 + l31, h = n / DQK, off = n % DQK; const int sc = h * DQK + (off < DNOPE ? off : DNOPE + rope_perm(off - DNOPE));
            tr_item(a.in[I_W_UQ] + (size_t)layer * QLORA * 768, 768, sc, a.in[I_Q_NORM] + layer * QLORA, (bf16_t*)(ws + WS_WUQ) + (size_t)layer * 768 * QLORA, QLORA, kb * 64, nb * 32, scr, lane); continue; } r -= I_UQ;
        if (r < I_UKV) { const int kb = r / 32, nb = r % 32;
            tr_item(a.in[I_W_UKV] + (size_t)layer * KVLORA * 1024, 1024, nb * 32 + l31, a.in[I_KV_NORM] + layer * KVLORA, (bf16_t*)(ws + WS_WUKV) + (size_t)layer * 1024 * KVLORA, KVLORA, kb * 64, nb * 32, scr, lane); continue; } r -= I_UKV;
        if (r < I_A) { const int kb = r / 32, nb = r % 32;
            tr_item(a.in[I_W_A] + (size_t)layer * 512 * DM, DM, nb * 32 + l31, nullptr, (bf16_t*)(ws + WS_WA) + (size_t)layer * DM * 512, 512, kb * 64, nb * 32, scr, lane); continue; } r -= I_A;
        if (r < I_B) { const int kb = r / 32, nb = r % 32;
            tr_item(a.in[I_W_B] + (size_t)layer * 256 * DM, DM, nb * 32 + l31, nullptr, (bf16_t*)(ws + WS_WB) + (size_t)layer * DM * 256, 256, kb * 64, nb * 32, scr, lane); continue; } r -= I_B;
        if (r < I_O) { const int kb = r / 32, nb = r % 32;
            tr_item(a.in[I_W_OUT] + (size_t)layer * DM * DM, DM, nb * 32 + l31, nullptr, (bf16_t*)(ws + WS_WO) + (size_t)layer * DM * DM, DM, kb * 64, nb * 32, scr, lane); continue; } r -= I_O;
        if (r < I_PG) { const int kb = r / 32, nb = r % 32;
            tr_item(a.in[I_W_PG] + (size_t)layer * DM * DM, DM, nb * 32 + l31, a.in[I_PLE_NORM] + layer * DM, (bf16_t*)(ws + WS_WPG) + (size_t)layer * DM * DM, DM, kb * 64, nb * 32, scr, lane); continue; } r -= I_PG;
        { const int kb = r / 32, nb = r % 32;
            tr_item(a.in[I_W_PP] + (size_t)layer * PLE * DM, DM, nb * 32 + l31, nullptr, (bf16_t*)(ws + WS_WPP) + (size_t)layer * DM * PLE, PLE, kb * 64, nb * 32, scr, lane); }
    }
}
__device__ __forceinline__ void convert_experts(const KArgs& a, unsigned char* ws, int layer, LAS float* scr, int gw, int NGW, int lane) {
    constexpr int I_GU = 16 * 64, I_D = 16 * 32, PER_E = I_GU + I_D;
    const int l31 = lane & 31;
    for (int it = gw; it < NE * PER_E; it += NGW) {
        const int e = it / PER_E; int r = it % PER_E;
        if (r < I_GU) { const int kb = r / 64, nb = r % 64, n = nb * 32 + l31, pn = n >> 8, j = n & 255;
            const float* src = (j < 128 ? a.in[I_W_GATE] : a.in[I_W_UP]) + ((size_t)layer * NE + e) * DM * DE;
            tr_item(src, DE, pn * 128 + (j & 127), a.in[I_FFN_NORM] + layer * DM, (bf16_t*)(ws + WS_WGU) + (size_t)e * 2048 * DM, DM, kb * 64, nb * 32, scr, lane);
        } else { r -= I_GU; const int kb = r / 32, nb = r % 32;
            tr_item(a.in[I_W_DOWN] + ((size_t)layer * NE + e) * DE * DM, DM, nb * 32 + l31, nullptr, (bf16_t*)(ws + WS_WD) + (size_t)e * DM * DE, DE, kb * 64, nb * 32, scr, lane); }
    }
}

__global__ void __launch_bounds__(NTHR, 2) mega_fwd(KArgs args) {
    extern __shared__ __attribute__((aligned(16))) unsigned char lds_raw[];
    LAS unsigned char* lds = (LAS unsigned char*)lds_raw;
    LAS unsigned* LC = (LAS unsigned*)(lds + LDSCTL_OFF);
    const int tid0 = threadIdx.x; const int wave0 = __builtin_amdgcn_readfirstlane(tid0 >> 6);
    const int G0 = gridDim.x; const int bx0 = blockIdx.x;
    unsigned char* const ws0 = args.ws; float* const out0 = args.out;
    for (int u = tid0; u < (LDS_BYTES - LDSCTL_OFF) / 4; u += NTHR) LC[u] = 0u;
    __syncthreads();
    XcdBarrier bar = xcd_barrier_post((unsigned*)(ws0 + WS_CTL) + CW_BAR, (volatile LAS unsigned*)(LC + 8));
#define LAYER_VARS \
    const float* xin = layer == 0 ? args.in[I_X] : out; (void)xin; \
    float* rsp_attn = rssb + (size_t)RSP_ATTN * T; float* rsp_ffn = rssb + (size_t)RSP_FFN * T; float* rs_ffn = rssb + (size_t)RS_FFNF * T; float* rs_ple = rssb + (size_t)RS_PLE * T; \
    float* rsp_q = rssb + (size_t)RSP_Q * T; float* rsp_kv = rssb + (size_t)RSP_KV * T; \
    (void)rsp_attn; (void)rsp_ffn; (void)rs_ffn; (void)rs_ple; (void)rsp_q; (void)rsp_kv;
#define GRID_BAR() do { XcdBarrier b2_ = bar; unsigned long long bb_ = (unsigned long long)bar.bar; asm volatile("" : "+s"(bb_), "+s"(b2_.x)); b2_.bar = (unsigned*)(GAS unsigned*)bb_; xcd_barrier(b2_); } while (0)
#define PHASE_VARS \
    unsigned long long ws_ = (unsigned long long)ws0; asm volatile("" : "+s"(ws_)); unsigned char* ws = (unsigned char*)(GAS unsigned char*)ws_; unsigned long long out_ = (unsigned long long)out0; asm volatile("" : "+s"(out_)); float* out = (float*)(GAS float*)out_; \
    int wave = wave0; asm volatile("" : "+s"(wave)); int lane = (int)__builtin_amdgcn_mbcnt_hi(~0u, __builtin_amdgcn_mbcnt_lo(~0u, 0u)); asm volatile("" : "+v"(lane)); const int tid = wave * 64 + lane; \
    int G = G0, bx = bx0; asm volatile("" : "+s"(G), "+s"(bx)); const int vcu = (G % 8 == 0) ? (bx % 8) * (G / 8) + bx / 8 : bx; const int NGW = G * NWAVES, NGT = G * NTHR; (void)NGW; (void)NGT; (void)vcu; \
    const int gw = vcu * NWAVES + wave; const int gtid = vcu * NTHR + tid; (void)gw; (void)gtid; (void)lane; \
    unsigned* ctl = (unsigned*)(ws + WS_CTL); (void)ctl; \
    float* rssb = (float*)(ws + WS_RSS); float* cosT = (float*)(ws + WS_ROPE); float* sinT = cosT + 8192 * 16; (void)rssb; (void)sinT; \
    bf16_t* xbA = (bf16_t*)(ws + WS_XBA); bf16_t* xbB = (bf16_t*)(ws + WS_XBB); bf16_t* pb = (bf16_t*)(ws + WS_PB); bf16_t* ppb = (bf16_t*)(ws + WS_PP); \
    bf16_t* zm = (bf16_t*)(ws + WS_ZM); bf16_t* zd = (bf16_t*)(ws + WS_ZD); bf16_t* gt = (bf16_t*)(ws + WS_GT); \
    bf16_t* qb = (bf16_t*)(ws + WS_Q); bf16_t* kvb = (bf16_t*)(ws + WS_KV); bf16_t* krb = (bf16_t*)(ws + WS_KR); \
    bf16_t* oab = (bf16_t*)(ws + WS_OA); bf16_t* ogb = (bf16_t*)(ws + WS_OG); float* lseb = (float*)(ws + WS_LSE); bf16_t* obb = (bf16_t*)(ws + WS_OB); \
    bf16_t* mixb = (bf16_t*)(ws + WS_MIX); bf16_t* xg = (bf16_t*)(ws + WS_XG); bf16_t* hm = (bf16_t*)(ws + WS_HM); \
    int* asg = (int*)(ws + WS_ASG); float* tw = (float*)(ws + WS_TW); int* dstrow = (int*)(ws + WS_DST); float* rrow = (float*)(ws + WS_RROW); float* rwgt = (float*)(ws + WS_RW); \
    (void)xbA; (void)xbB; (void)pb; (void)ppb; (void)zm; (void)zd; (void)gt; (void)qb; (void)kvb; (void)krb; (void)oab; (void)ogb; (void)lseb; (void)obb; (void)mixb; (void)xg; (void)hm; (void)asg; (void)tw; (void)dstrow; (void)rrow; (void)rwgt; \
    bf16_t* xb0 = xbA; bf16_t* xb1 = xbB; (void)xb0; (void)xb1;

    if (PH(0)) { PHASE_VARS
        LAS float* scr = (LAS float*)(lds + wave * 16384);
        const float* x = args.in[I_X];
        for (int m = gw; m < T; m += NGW) {
            const f32x4* xr = (const f32x4*)(x + (size_t)m * DM) + lane; f32x4 v[4]; float s = 0.f;
#pragma unroll
            for (int j = 0; j < 4; ++j) { v[j] = xr[64 * j]; s += (v[j].x * v[j].x + v[j].y * v[j].y) + (v[j].z * v[j].z + v[j].w * v[j].w); }
            s = wave_sum(s);
            u32x2* o8 = (u32x2*)(xbA + (size_t)m * DM) + lane;
#pragma unroll
            for (int j = 0; j < 4; ++j) { u32x2 w; w.x = cvtpk(v[j].x, v[j].y); w.y = cvtpk(v[j].z, v[j].w); o8[64 * j] = w; }
            if (lane < 16) rssb[(size_t)RSP_ATTN * T + (size_t)m * 16 + lane] = lane == 0 ? s : 0.f;
        }
        { const float* p = args.in[I_P]; const size_t n8 = (size_t)2 * T * PLE / 8;
          for (size_t i = gtid; i < n8; i += NGT) { const f32x4 a0 = *(const f32x4*)(p + i * 8), a1 = *(const f32x4*)(p + i * 8 + 4); *(u32x4*)(pb + i * 8) = pack8(a0, a1); } }
        for (int i = gtid; i < 8192 * 16; i += NGT) { const int pos = i >> 4, f = i & 15; const float inv = powf(10000.0f, -(float)f * 2.0f / 32.0f); const float ang = (float)pos * inv; cosT[i] = cosf(ang); sinT[i] = sinf(ang); }
        for (int i = gtid; i < 2 * 32768; i += NGT) { const int l = i >> 15, r = i & 32767, kc = r >> 8, ln = (r >> 2) & 63, j = r & 3; const int k = 8 * kc + 4 * (ln >> 5) + j, e = ln & 31;
            ((float*)(ws + WS_WR))[i] = args.in[I_FFN_NORM][l * DM + k] * args.in[I_W_ROUTER][((size_t)l * DM + k) * NE + e]; }
        convert_small(args, ws, 0, scr, gw, NGW, lane);
        convert_small(args, ws, 1, scr, gw, NGW, lane);
        convert_experts(args, ws, 0, scr, gw, NGW, lane);
    }
    GRID_BAR();

#pragma unroll
    for (int layer = 0; layer < DEPTH; ++layer) {
        if (PH(1)) { PHASE_VARS LAYER_VARS
            pg8::Gemm g{DM, DM, DM}; pg8::DenseSched S; S.init(xb0, DM, (bf16_t*)(ws + WS_WIN) + (size_t)layer * ZC * DM, DM, T, ZC, G, bx);
            pg8::EpiZ E{rsp_attn, rsp_q, rsp_kv, zm, zd, gt, krb, cosT, sinT};
            pg8::gemm_phase<pg8::EpiZ, pg8::DenseSched, true>(lds, g, S, E, wave);
        }
        GRID_BAR();

        if (PH(2)) { PHASE_VARS LAYER_VARS
            { pg8::Gemm g{ZM_LD, QLORA, QLORA}; pg8::DenseSched S; S.init(zm + 256, ZM_LD, (bf16_t*)(ws + WS_WUQ) + (size_t)layer * 768 * QLORA, QLORA, T, 768, G, bx);
              pg8::EpiGen E{qb, Q_LD, rsp_q, 2, 1.0f / QLORA, C2_MLA, nullptr, 0, nullptr, 0};
              pg8::gemm_phase<pg8::EpiGen, pg8::DenseSched, true>(lds, g, S, E, wave); }
            { pg8::Gemm g{ZM_LD, KVLORA, KVLORA}; pg8::DenseSched S; S.init(zm, ZM_LD, (bf16_t*)(ws + WS_WUKV) + (size_t)layer * 1024 * KVLORA, KVLORA, T, 1024, G, bx);
              pg8::EpiGen E{kvb, KV_LD, rsp_kv, 1, 1.0f / KVLORA, 1.0f, nullptr, 0, nullptr, 0};
              pg8::gemm_phase<pg8::EpiGen, pg8::DenseSched, true>(lds, g, S, E, wave); }
            const int per_cu = (1536 + G - 1) / G;
            for (int ui = vcu * per_cu; ui < 1536 && ui < (vcu + 1) * per_cu; ++ui) {
                const int uin = ui & 31, h = (ui >> 5) & 3, gq = (ui >> 7) % 3, b = ui / 384;
                const int dil = gq == 0 ? 1 : (gq == 1 ? 4 : 16); const int nblk = SEQ / (256 * dil); const int r = uin / nblk, u = uin % nblk;
                const long tok0 = (long)b * SEQ + (long)256 * u * dil + r;
                att::Args A;
                A.Q = zd + tok0 * ZD_LD + gq * 768 + h * 64; A.ldq = (long)dil * ZD_LD;
                A.K = zd + (tok0 - (long)128 * dil) * ZD_LD + gq * 768 + 256 + h * 64; A.ldk = (long)dil * ZD_LD; A.K2 = nullptr; A.ldk2 = 0;
                A.V = zd + (tok0 - (long)128 * dil) * ZD_LD + gq * 768 + 512 + h * 64; A.ldv = (long)dil * ZD_LD;
                A.O = ogb + (size_t)gq * T * 256 + tok0 * 256 + h * 64; A.ldo = (long)dil * 256;
                A.lse = lseb + (size_t)gq * T * 4 + tok0 * 4 + h; A.ldlse = (long)dil * 4;
                A.t0 = (u == 0) ? 2 : 0; A.t1 = 6; A.qoff = 128; A.tmask = 0; A.cosT = nullptr; A.sinT = nullptr;
                { const int si = gq * 4 + h;
                  const float ex = si < 8 ? 0.5f * (float)(si + 1) : (float)(si - 3);
                  A.ab = exp2f(-ex) * (float)dil * LOG2E; }
                att::attn_unit<1>(A, (LAS char*)lds, wave);
            }
        }
        GRID_BAR();

        if (PH(3)) { PHASE_VARS LAYER_VARS
            const int nun = (G == 256) ? 4 : (1024 + G - 1) / G;
            for (int i = 0; i < nun; ++i) {
                int bh, qblk;
                if (G == 256) { const int s = vcu & 7; bh = vcu >> 3; qblk = (i == 0) ? 31 - s : (i == 1) ? 16 + s : (i == 2) ? 15 - s : s; }
                else { const int ui = i * G + vcu; if (ui >= 1024) break; bh = ui >> 5; qblk = ui & 31; }
                const int b = bh >> 3, h = bh & 7; const long row0 = (long)b * SEQ;
                att::Args A;
                A.Q = qb + (row0 + 256 * qblk) * Q_LD + h * DQK; A.ldq = Q_LD;
                A.K = kvb + row0 * KV_LD + h * 128; A.ldk = KV_LD; A.K2 = krb + row0 * 32; A.ldk2 = 32;
                A.V = kvb + row0 * KV_LD + h * 128 + 64; A.ldv = KV_LD;
                A.O = oab + (row0 + 256 * qblk) * 512 + h * 64; A.ldo = 512; A.lse = nullptr; A.ldlse = 0;
                A.t0 = 0; A.t1 = 4 * (qblk + 1); A.qoff = 256 * qblk; A.tmask = 4 * qblk; A.ab = 0.f; A.cosT = cosT; A.sinT = sinT;
                att::attn_unit<0>(A, (LAS char*)lds, wave);
            }
            for (int m = gw; m < T; m += NGW) {
                const int h = lane >> 4;
                const float l0 = lseb[(size_t)0 * T * 4 + (size_t)m * 4 + h], l1 = lseb[(size_t)1 * T * 4 + (size_t)m * 4 + h], l2 = lseb[(size_t)2 * T * 4 + (size_t)m * 4 + h];
                const float mx = fmaxf(l0, fmaxf(l1, l2)); const float e0 = __expf(l0 - mx), e1 = __expf(l1 - mx), e2 = __expf(l2 - mx); const float inv = 1.0f / (e0 + e1 + e2);
                const u32x2 a0 = *(const u32x2*)(ogb + (size_t)0 * T * 256 + (size_t)m * 256 + lane * 4), a1 = *(const u32x2*)(ogb + (size_t)1 * T * 256 + (size_t)m * 256 + lane * 4), a2 = *(const u32x2*)(ogb + (size_t)2 * T * 256 + (size_t)m * 256 + lane * 4);
                const float w0 = e0 * inv, w1 = e1 * inv, w2 = e2 * inv;
                const float r0 = w0 * bflo(a0.x) + w1 * bflo(a1.x) + w2 * bflo(a2.x), r1 = w0 * bfhi(a0.x) + w1 * bfhi(a1.x) + w2 * bfhi(a2.x);
                const float r2 = w0 * bflo(a0.y) + w1 * bflo(a1.y) + w2 * bflo(a2.y), r3 = w0 * bfhi(a0.y) + w1 * bfhi(a1.y) + w2 * bfhi(a2.y);
                u32x2 w; w.x = cvtpk(r0, r1); w.y = cvtpk(r2, r3); *(u32x2*)(obb + (size_t)m * 256 + lane * 4) = w;
            }
        }
        GRID_BAR();

        if (PH(5)) { PHASE_VARS LAYER_VARS
            { pg8::Gemm g{256, 256, 256}; pg8::DenseSched S; S.init(obb, 256, (bf16_t*)(ws + WS_WB) + (size_t)layer * DM * 256, 256, T, DM, G, bx);
              pg8::EpiGen E{mixb, DM, nullptr, 0, 0.f, 1.0f, gt + 1024, GT_LD, nullptr, 0};
              pg8::gemm_phase<pg8::EpiGen, pg8::DenseSched, true>(lds, g, S, E, wave); }
            { pg8::Gemm g{512, 512, 512}; pg8::DenseSched S; S.init(oab, 512, (bf16_t*)(ws + WS_WA) + (size_t)layer * DM * 512, 512, T, DM, G, bx);
              pg8::EpiGen E{mixb, DM, nullptr, 0, 0.f, 1.0f, gt, GT_LD, mixb, DM};
              pg8::gemm_phase<pg8::EpiGen, pg8::DenseSched, true>(lds, g, S, E, wave); }
            { pg8::Gemm g{PLE, PLE, PLE}; pg8::DenseSched S; S.init(pb + (size_t)layer * T * PLE, PLE, (bf16_t*)(ws + WS_WPP) + (size_t)layer * DM * PLE, PLE, T, DM, G, bx);
              pg8::EpiGen E{ppb, DM, nullptr, 0, 0.f, 1.0f, nullptr, 0, nullptr, 0};
              pg8::gemm_phase<pg8::EpiGen, pg8::DenseSched, true>(lds, g, S, E, wave); }
        }
        GRID_BAR();

        if (PH(6)) { PHASE_VARS LAYER_VARS
            pg8::Gemm g{DM, DM, DM}; pg8::DenseSched S; S.init(mixb, DM, (bf16_t*)(ws + WS_WO) + (size_t)layer * DM * DM, DM, T, DM, G, bx);
            pg8::EpiRes<false> E{xin, out, xb1, rsp_ffn, nullptr, nullptr};
            pg8::gemm_phase<pg8::EpiRes<false>, pg8::DenseSched, true>(lds, g, S, E, wave);
        }
        GRID_BAR();

        if (PH(7)) { PHASE_VARS LAYER_VARS
            const float* wr2 = (const float*)(ws + WS_WR) + (size_t)layer * 32768;
            const float* brt = args.in[I_B_ROUTER] + layer * NE;
            unsigned* cnt = ctl + CW_CNT + layer * NE;
            LAS float* exch = (LAS float*)lds;
            LAS int* hist = (LAS int*)(LC + LT_HIST); LAS int* base = (LAS int*)(LC + LT_BASE);
            const int tile = wave & 3, kh = wave >> 2, r32 = lane & 31, hi = lane >> 5;
            for (int tb = vcu; tb < T / 128; tb += G) {
                const int tok = tb * 128 + tile * 32 + r32;
                const float* xp = out + (size_t)tok * DM + kh * 512 + 4 * hi;
                const float* wp = wr2 + ((size_t)(kh * 64) * 64 + lane) * 4;
                f32x16 acc = {};
#pragma unroll 4
                for (int c = 0; c < 64; ++c) { const f32x4 xv = *(const f32x4*)(xp + 8 * c); const f32x4 wv = *(const f32x4*)(wp + (size_t)c * 256);
                    acc = __builtin_amdgcn_mfma_f32_32x32x2f32(wv.x, xv.x, acc, 0, 0, 0); acc = __builtin_amdgcn_mfma_f32_32x32x2f32(wv.y, xv.y, acc, 0, 0, 0);
                    acc = __builtin_amdgcn_mfma_f32_32x32x2f32(wv.z, xv.z, acc, 0, 0, 0); acc = __builtin_amdgcn_mfma_f32_32x32x2f32(wv.w, xv.w, acc, 0, 0, 0); }
                if (kh == 1) {
#pragma unroll
                    for (int r = 0; r < 16; ++r) exch[(tile * 16 + r) * 64 + lane] = acc[r]; }
                __syncthreads();
                int idx[4] = {0, 0, 0, 0}; float wgt[4] = {0.f, 0.f, 0.f, 0.f}; int lrank[4] = {0, 0, 0, 0};
                if (kh == 0) {
                    const float rsum = sum16(rsp_ffn + (size_t)tok * 16); if (hi == 0) rs_ffn[tok] = rsum;
                    const float rstd = __builtin_amdgcn_rsqf(rsum * (1.0f / DM) + EPS);
                    float v[16];
#pragma unroll
                    for (int r = 0; r < 16; ++r) v[r] = (acc[r] + exch[(tile * 16 + r) * 64 + lane]) * rstd + brt[crow(r, hi)];
                    float tv[4]; int ti[4];
#pragma unroll
                    for (int t = 0; t < 4; ++t) { float best = -INFINITY; int bi = 0;
#pragma unroll
                        for (int r = 0; r < 16; ++r) { if (v[r] > best) { best = v[r]; bi = r; } }
                        tv[t] = best; ti[t] = crow(bi, hi);
#pragma unroll
                        for (int r = 0; r < 16; ++r) v[r] = (r == bi) ? -INFINITY : v[r]; }
                    float cv[8]; int ci[8];
#pragma unroll
                    for (int t = 0; t < 4; ++t) { cv[t] = tv[t]; ci[t] = ti[t]; cv[4 + t] = __shfl_xor(tv[t], 32); ci[4 + t] = __shfl_xor(ti[t], 32); }
#pragma unroll
                    for (int t = 0; t < 4; ++t) { float best = -INFINITY; int be = 1 << 30; int bi = 0;
#pragma unroll
                        for (int r = 0; r < 8; ++r) { if (cv[r] > best || (cv[r] == best && ci[r] < be)) { best = cv[r]; be = ci[r]; bi = r; } }
                        wgt[t] = best; idx[t] = be;
#pragma unroll
                        for (int r = 0; r < 8; ++r) cv[r] = (r == bi) ? -INFINITY : cv[r]; }
                    const float e1 = __expf(wgt[1] - wgt[0]), e2 = __expf(wgt[2] - wgt[0]), e3 = __expf(wgt[3] - wgt[0]); const float inv = 1.0f / (1.0f + e1 + e2 + e3);
                    wgt[0] = inv; wgt[1] = e1 * inv; wgt[2] = e2 * inv; wgt[3] = e3 * inv;
                    if (hi == 0) {
#pragma unroll
                        for (int t = 0; t < 4; ++t) lrank[t] = __hip_atomic_fetch_add(hist + idx[t], 1, __ATOMIC_RELAXED, __HIP_MEMORY_SCOPE_WORKGROUP); }
                }
                __syncthreads();
                if (tid < NE) { const int hcount = hist[tid]; base[tid] = (int)__hip_atomic_fetch_add(cnt + tid, (unsigned)hcount, __ATOMIC_RELAXED, __HIP_MEMORY_SCOPE_AGENT); hist[tid] = 0; }
                __syncthreads();
                if (kh == 0 && hi == 0) {
#pragma unroll
                    for (int t = 0; t < 4; ++t) { asg[(size_t)tok * 4 + t] = (idx[t] << 16) | (base[idx[t]] + lrank[t]); tw[(size_t)tok * 4 + t] = wgt[t]; } }
                __syncthreads();
            }
        }
        GRID_BAR();

        if (PH(8)) { PHASE_VARS LAYER_VARS
            LAS int* ucum = (LAS int*)(LC + LT_UCUM); LAS int* rb0 = (LAS int*)(LC + LT_RB0);
            const unsigned* cnt = ctl + CW_CNT + layer * NE;
            if (tid == 0) { int rb = 0; for (int e = 0; e < NE; ++e) { const int c = (int)__hip_atomic_load(cnt + e, __ATOMIC_RELAXED, __HIP_MEMORY_SCOPE_AGENT); rb0[e] = rb; rb += (c + 255) >> 8; } rb0[NE] = rb; }
            __syncthreads();
            for (int m = gw; m < T; m += NGW) {
                const float rstd = __builtin_amdgcn_rsqf(rs_ffn[m] * (1.0f / DM) + EPS);
                const u32x4 a0 = *(const u32x4*)(xb1 + (size_t)m * DM + lane * 8), a1 = *(const u32x4*)(xb1 + (size_t)m * DM + 512 + lane * 8);
#pragma unroll
                for (int t = 0; t < 4; ++t) { const int a = asg[(size_t)m * 4 + t]; const int e = a >> 16, slot = a & 0xffff; const int dst = rb0[e] * 256 + slot;
                    *(u32x4*)(xg + (size_t)dst * DM + lane * 8) = a0; *(u32x4*)(xg + (size_t)dst * DM + 512 + lane * 8) = a1;
                    if (lane == 0) { rrow[dst] = rstd; rwgt[dst] = tw[(size_t)m * 4 + t]; dstrow[(size_t)m * 4 + t] = dst; } }
            }
        }
        GRID_BAR();

        if (PH(9)) { PHASE_VARS LAYER_VARS
            LAS int* ucum = (LAS int*)(LC + LT_UCUM); LAS int* rb0 = (LAS int*)(LC + LT_RB0);
            if (tid == 0) { int uc = 0; for (int e = 0; e < NE; ++e) { ucum[e] = uc; uc += (rb0[e + 1] - rb0[e]) * 8; } ucum[NE] = uc; }
            __syncthreads();
            pg8::Gemm g{DM, DM, DM};
            pg8::MoeSched S{(const char*)xg, (const char*)(ws + WS_WGU), (size_t)256 * DM * 2, (size_t)256 * DM * 2, (size_t)2048 * DM * 2, 8, G, bx, ucum, rb0};
            pg8::EpiSwiglu E{hm, rrow, args.in[I_B_GATE] + (size_t)layer * NE * DE, args.in[I_B_UP] + (size_t)layer * NE * DE};
            pg8::gemm_phase<pg8::EpiSwiglu, pg8::MoeSched, true>(lds, g, S, E, wave);
        }
        GRID_BAR();

        if (PH(10)) { PHASE_VARS LAYER_VARS
            LAS int* ucum = (LAS int*)(LC + LT_UCUM); LAS int* rb0 = (LAS int*)(LC + LT_RB0);
            __syncthreads();
            if (tid == 0) { int uc = 0; for (int e = 0; e < NE; ++e) { ucum[e] = uc; uc += (rb0[e + 1] - rb0[e]) * 4; } ucum[NE] = uc; }
            __syncthreads();
            pg8::Gemm g{DE, DE, DE};
            pg8::MoeSched S{(const char*)hm, (const char*)(ws + WS_WD), (size_t)256 * DE * 2, (size_t)256 * DE * 2, (size_t)DM * DE * 2, 4, G, bx, ucum, rb0};
            pg8::EpiDown E{xg, rwgt, args.in[I_B_DOWN] + (size_t)layer * NE * DM};
            pg8::gemm_phase<pg8::EpiDown, pg8::MoeSched, true>(lds, g, S, E, wave);
        }
        GRID_BAR();

        if (PH(11)) { PHASE_VARS LAYER_VARS
            for (int m = gw; m < T; m += NGW) {
                float* xr = out + (size_t)m * DM;
                f32x4 v0 = *(const f32x4*)(xr + lane * 8), v1 = *(const f32x4*)(xr + lane * 8 + 4), v2 = *(const f32x4*)(xr + 512 + lane * 8), v3 = *(const f32x4*)(xr + 512 + lane * 8 + 4);
#pragma unroll
                for (int t = 0; t < 4; ++t) { const int dst = dstrow[(size_t)m * 4 + t]; f32x4 a, b;
                    unpack8(*(const u32x4*)(xg + (size_t)dst * DM + lane * 8), a, b); v0 = v0 + a; v1 = v1 + b;
                    unpack8(*(const u32x4*)(xg + (size_t)dst * DM + 512 + lane * 8), a, b); v2 = v2 + a; v3 = v3 + b; }
                *(f32x4*)(xr + lane * 8) = v0; *(f32x4*)(xr + lane * 8 + 4) = v1; *(f32x4*)(xr + 512 + lane * 8) = v2; *(f32x4*)(xr + 512 + lane * 8 + 4) = v3;
                *(u32x4*)(xb1 + (size_t)m * DM + lane * 8) = pack8(v0, v1); *(u32x4*)(xb1 + (size_t)m * DM + 512 + lane * 8) = pack8(v2, v3);
                float s = 0.f;
#pragma unroll
                for (int i = 0; i < 4; ++i) s += v0[i] * v0[i] + v1[i] * v1[i] + v2[i] * v2[i] + v3[i] * v3[i];
                s = wave_sum(s);
                if (lane == 0) rs_ple[m] = s;
            }
            if (layer == 0) { __syncthreads(); convert_experts(args, ws, 1, (LAS float*)(lds + wave * 16384), gw, NGW, lane); }
        }
        GRID_BAR();

        if (PH(12)) { PHASE_VARS LAYER_VARS
            pg8::Gemm g{DM, DM, DM}; pg8::DenseSched S; S.init(xb1, DM, (bf16_t*)(ws + WS_WPG) + (size_t)layer * DM * DM, DM, T, DM, G, bx);
            pg8::EpiRes<true> E{out, out, xb0, rsp_attn, rs_ple, ppb};
            pg8::gemm_phase<pg8::EpiRes<true>, pg8::DenseSched, true>(lds, g, S, E, wave);
        }
        GRID_BAR();
    }

    if (PH(13)) { PHASE_VARS
        const float* fg = args.in[I_FINAL_NORM];
        const unsigned bad = __hip_atomic_load(ctl + CW_BAR + XB_TMO, __ATOMIC_RELAXED, __HIP_MEMORY_SCOPE_AGENT);
        for (int m = gw; m < T; m += NGW) {
            f32x4* xr = (f32x4*)(out + (size_t)m * DM) + lane; f32x4 v[4]; float s = 0.f;
#pragma unroll
            for (int j = 0; j < 4; ++j) { v[j] = xr[64 * j]; s += (v[j].x * v[j].x + v[j].y * v[j].y) + (v[j].z * v[j].z + v[j].w * v[j].w); }
            s = wave_sum(s);
            float rstd = __builtin_amdgcn_rsqf(s * (1.0f / DM) + EPS);
            if (bad) rstd = __builtin_nanf("");
#pragma unroll
            for (int j = 0; j < 4; ++j) { const f32x4 gg = *((const f32x4*)fg + lane + 64 * j); xr[64 * j] = v[j] * rstd * gg; }
        }
    }
}

extern "C" void kernel_launch(void* const* d_in, const int* in_sizes, int n_in, void* d_out, int out_size, void* d_ws, size_t ws_size, hipStream_t stream) {
    static int grid = 0;
    if (grid == 0) {
        if (n_in != 24 || out_size != T * DM || ws_size < WS_END) { fprintf(stderr, "kernel_launch: shape mismatch n_in %d out %d ws %zu (need %zu)\n", n_in, out_size, ws_size, (size_t)WS_END); grid = -1; return; }
        int dev = 0, cus = 0, per_cu = 0;
        if (hipGetDevice(&dev) != hipSuccess || hipDeviceGetAttribute(&cus, hipDeviceAttributeMultiprocessorCount, dev) != hipSuccess) { grid = -1; return; }
        if (hipFuncSetAttribute((const void*)mega_fwd, hipFuncAttributeMaxDynamicSharedMemorySize, LDS_BYTES) != hipSuccess) { fprintf(stderr, "kernel_launch: hipFuncSetAttribute failed\n"); grid = -1; return; }
        if (hipOccupancyMaxActiveBlocksPerMultiprocessor(&per_cu, (const void*)mega_fwd, NTHR, LDS_BYTES) != hipSuccess || per_cu < 1) { fprintf(stderr, "kernel_launch: occupancy query says %d\n", per_cu); }
        (void)hipGetLastError();
        grid = cus;
    }
    if (grid < 0) return;
    if (hipMemsetAsync((char*)d_ws + WS_CTL, 0, ZERO_BYTES, stream) != hipSuccess) return;
    KArgs a{};
    for (int i = 0; i < 24; ++i) a.in[i] = (const float*)d_in[i];
    a.out = (float*)d_out; a.ws = (unsigned char*)d_ws;
    hipLaunchKernelGGL(mega_fwd, dim3(grid), dim3(NTHR), LDS_BYTES, stream, a);
}
```

```cpp
#include <hip/hip_runtime.h>
#include <cstdio>
#include <cstdint>

#define GAS __attribute__((address_space(1)))
#define LAS __attribute__((address_space(3)))
typedef unsigned short bf16_t;
typedef short bf16x8 __attribute__((ext_vector_type(8)));
typedef short s16x4 __attribute__((ext_vector_type(4)));
typedef float f32x2 __attribute__((ext_vector_type(2)));
typedef float f32x4 __attribute__((ext_vector_type(4)));
typedef float f32x16 __attribute__((ext_vector_type(16)));
typedef unsigned u32x2 __attribute__((ext_vector_type(2)));
typedef unsigned u32x4 __attribute__((ext_vector_type(4)));
typedef __bf16 bf16x2_t __attribute__((ext_vector_type(2)));
typedef int v8i __attribute__((ext_vector_type(8)));
typedef int v4i __attribute__((ext_vector_type(4)));

constexpr int BATCH = 4, SEQ = 8192, T = BATCH * SEQ, DM = 1024, DEPTH = 2, PLE = 256;
constexpr int NE = 32, DE = 1024;
constexpr int IN_COLS = 5024, ZC = 5120;
constexpr int QLORA = 384, KVLORA = 256, NH = 8, DQK = 96, DNOPE = 64, DROPE = 32, DV = 64;
constexpr int ZM_LD = 768, ZD_LD = 2304, GT_LD = 2048, Q_LD = 768, KV_LD = 1024;
constexpr int RMAXB = 544, RMAX = RMAXB * 256;
constexpr float EPS = 1e-6f;
constexpr float LOG2E = 1.4426950408889634f;
constexpr float C2_MLA = 0.10206207261596577f * LOG2E;
constexpr float C2_DIL = 0.125f * LOG2E;
constexpr int NWAVES = 8, NTHR = 512;
#ifndef PHASE_MASK
#define PHASE_MASK 0xFFFFFFFFu
#endif
#define PH(k) ((PHASE_MASK >> (k)) & 1u)
#ifndef DIAG
#define DIAG 0
#endif
#define REP_MASK 0u
#define NREP(k) (1 + (int)((REP_MASK >> (k)) & 1u))
#ifndef DIAG_A_MASK
#define DIAG_A_MASK 0u
#endif
#ifndef DIAG_B_MASK
#define DIAG_B_MASK 0u
#endif

constexpr size_t MiB = 1u << 20;
constexpr size_t al(size_t x) { return (x + 255) / 256 * 256; }
constexpr size_t WS_CTL = 0;
constexpr size_t WS_RSS = 1 * MiB;
constexpr size_t ZERO_BYTES = 65536;
constexpr size_t WS_ROPE = al(WS_RSS + (size_t)47 * T * 4);
constexpr size_t WS_WR = WS_ROPE + 2 * 8192 * 16 * 4;
constexpr size_t WS_WIN = WS_WR + 2 * 32768 * 4;
constexpr size_t WS_WUQ = WS_WIN + (size_t)2 * ZC * DM * 2;
constexpr size_t WS_WUKV = WS_WUQ + (size_t)2 * 768 * 384 * 2;
constexpr size_t WS_WA = WS_WUKV + (size_t)2 * 1024 * 256 * 2;
constexpr size_t WS_WB = WS_WA + (size_t)2 * 1024 * 512 * 2;
constexpr size_t WS_WO = WS_WB + (size_t)2 * 1024 * 256 * 2;
constexpr size_t WS_WPG = WS_WO + (size_t)2 * 1024 * 1024 * 2;
constexpr size_t WS_WPP = WS_WPG + (size_t)2 * 1024 * 1024 * 2;
constexpr size_t WS_WGU = WS_WPP + (size_t)2 * 1024 * 256 * 2;
constexpr size_t WS_WD = WS_WGU + (size_t)2 * NE * 2048 * 1024;
constexpr size_t WS_XBA = WS_WD + (size_t)2 * NE * 1024 * 1024;
constexpr size_t WS_XBB = WS_XBA + (size_t)T * DM;
constexpr size_t WS_PB = WS_XBB + (size_t)T * DM * 2;
constexpr size_t WS_ASG = WS_PB + (size_t)2 * T * PLE * 2;
constexpr size_t WS_TW = WS_ASG + (size_t)T * 4 * 4;
constexpr size_t WS_DST = WS_TW + (size_t)T * 4 * 4;
constexpr size_t WS_TOKL = WS_DST + (size_t)T * 4 * 4;
constexpr size_t WS_WL = WS_TOKL + (size_t)NE * 32768 * 4;
constexpr size_t WS_XQ = WS_WL + (size_t)NE * 32768 * 4;
constexpr size_t WS_X3B = WS_XQ + (size_t)T * DM;
constexpr size_t WS_U = al(WS_X3B + (size_t)T * DM * 2);
constexpr size_t WS_ZM = WS_U;
constexpr size_t WS_ZD = WS_ZM + (size_t)T * ZM_LD * 2;
constexpr size_t WS_GT = WS_ZD + (size_t)T * ZD_LD * 2;
constexpr size_t WS_Q = WS_GT + (size_t)T * GT_LD * 2;
constexpr size_t WS_KV = WS_Q + (size_t)T * Q_LD * 2;
constexpr size_t WS_KR = WS_KV + (size_t)T * KV_LD * 2;
constexpr size_t WS_OA = WS_KR + (size_t)T * 32 * 2;
constexpr size_t WS_OG = WS_OA + (size_t)T * 512 * 2;
constexpr size_t WS_LSE = WS_OG + (size_t)3 * T * 256 * 2;
constexpr size_t WS_OB = WS_LSE + (size_t)3 * T * 4 * 4;
constexpr size_t WS_MIXER_END = WS_OB + (size_t)T * 256 * 2;
constexpr size_t WS_MIX = WS_ZD;
constexpr size_t WS_PP = WS_Q;
constexpr size_t WS_Y = WS_U;
constexpr size_t WS_HM = WS_Y + (size_t)RMAX * DM;
constexpr size_t WS_MOE_END = WS_HM + (size_t)RMAX * DE;
constexpr size_t WS_END = WS_MIXER_END > WS_MOE_END ? WS_MIXER_END : WS_MOE_END;
static_assert(WS_END <= (size_t)1024 * MiB, "workspace map must fit 1 GiB");
static_assert(WS_ZD + (size_t)T * DM * 2 <= WS_GT, "MIX overlay inside zd");
static_assert(WS_MOE_END <= WS_PP && WS_PP + (size_t)T * DM * 2 <= WS_KR, "PP overlay: after the MoE view, inside q | kv");

constexpr int CW_BAR = 4096;
constexpr int CW_CNT = 8192;
constexpr int CW_KMAX = 12288;
enum { RSP_ATTN = 0, RSP_FFN = 16, RSP_Q = 32, RSP_KV = 40, RS_FFNF = 44, RS_PLE = 45, RS_ATTNF = 46 };

constexpr int RING_BYTES = 131072;
constexpr int LDSCTL_OFF = RING_BYTES;
constexpr int LT_MISC = 0, LT_UCUM = 64, LT_RB0 = 128, LT_HIST = 192, LT_BASE = 256;
constexpr int RL_OFF = 147456;
constexpr int LDS_BYTES = 163840;

#define LDS_WAIT() asm volatile("s_waitcnt lgkmcnt(0)" ::: "memory")
#define VM_WAIT() asm volatile("s_waitcnt vmcnt(0)" ::: "memory")
__device__ __forceinline__ unsigned cvtpk(float lo, float hi) { f32x2 v = {lo, hi}; bf16x2_t b = __builtin_convertvector(v, bf16x2_t); return __builtin_bit_cast(unsigned, b); }
__device__ __forceinline__ u32x4 pack8(f32x4 a, f32x4 b) { u32x4 w; w.x = cvtpk(a[0], a[1]); w.y = cvtpk(a[2], a[3]); w.z = cvtpk(b[0], b[1]); w.w = cvtpk(b[2], b[3]); return w; }
__device__ __forceinline__ unsigned pk4_fp8(float a, float b, float c, float d) {
    a = fminf(fmaxf(a, -448.f), 448.f); b = fminf(fmaxf(b, -448.f), 448.f); c = fminf(fmaxf(c, -448.f), 448.f); d = fminf(fmaxf(d, -448.f), 448.f);
    int w = 0; w = __builtin_amdgcn_cvt_pk_fp8_f32(a, b, w, false); w = __builtin_amdgcn_cvt_pk_fp8_f32(c, d, w, true); return (unsigned)w; }
__device__ __forceinline__ unsigned pk4_fp8_nc(float a, float b, float c, float d) { int w = 0; w = __builtin_amdgcn_cvt_pk_fp8_f32(a, b, w, false); w = __builtin_amdgcn_cvt_pk_fp8_f32(c, d, w, true); return (unsigned)w; }
__device__ __forceinline__ f32x4 unpack4_fp8(unsigned w) { const auto lo = __builtin_amdgcn_cvt_pk_f32_fp8((int)w, false); const auto hi = __builtin_amdgcn_cvt_pk_f32_fp8((int)w, true); return (f32x4){lo[0], lo[1], hi[0], hi[1]}; }
__device__ __forceinline__ float bflo(unsigned w) { return __uint_as_float(w << 16); }
__device__ __forceinline__ float bfhi(unsigned w) { return __uint_as_float(w & 0xffff0000u); }
__device__ __forceinline__ void unpack8(u32x4 w, f32x4& a, f32x4& b) { a = (f32x4){bflo(w.x), bfhi(w.x), bflo(w.y), bfhi(w.y)}; b = (f32x4){bflo(w.z), bfhi(w.z), bflo(w.w), bfhi(w.w)}; }
__device__ __forceinline__ float fsigmoid(float x) { return __builtin_amdgcn_rcpf(1.0f + __builtin_amdgcn_exp2f(-x * LOG2E)); }
template <int X> __device__ __forceinline__ float sx(float v) { return __int_as_float(__builtin_amdgcn_ds_swizzle(__float_as_int(v), (X << 10) | 0x1f)); }
__device__ __forceinline__ float sum32(float v) { auto rr = __builtin_amdgcn_permlane32_swap(__float_as_uint(v), __float_as_uint(v), false, false); return __uint_as_float(rr[0]) + __uint_as_float(rr[1]); }
__device__ __forceinline__ float max32(float v) { auto rr = __builtin_amdgcn_permlane32_swap(__float_as_uint(v), __float_as_uint(v), false, false); return fmaxf(__uint_as_float(rr[0]), __uint_as_float(rr[1])); }
__device__ __forceinline__ float wave_sum(float v) { v += sx<1>(v); v += sx<2>(v); v += sx<4>(v); v += sx<8>(v); v += sx<16>(v); return sum32(v); }
__device__ __forceinline__ float sum4(const float* p) { const f32x4 a = *(const f32x4*)p; return (a[0] + a[1]) + (a[2] + a[3]); }
__device__ __forceinline__ float sum16(const float* p) { return (sum4(p) + sum4(p + 4)) + (sum4(p + 8) + sum4(p + 12)); }
__device__ __forceinline__ int crow(int r, int hi) { return (r & 3) + 8 * (r >> 2) + 4 * hi; }

#define XB_TMO      128
#define XB_XCNT(j)  (256  + 64 * (j))
#define XB_XSUB(j)  (1280 + 64 * (j))
#define XB_XGEN(j)  (2304 + 64 * (j))
#define XB_TOP      3328
#define XB_TOPGEN   3392
#define XCD_BAR_WORDS 3456
#define XB_SPIN_CAP (1u << 18)
__device__ __forceinline__ unsigned xb_ld(unsigned* p)              { return __hip_atomic_load(p, __ATOMIC_RELAXED, __HIP_MEMORY_SCOPE_AGENT); }
__device__ __forceinline__ unsigned xb_add(unsigned* p, unsigned v) { return __hip_atomic_fetch_add(p, v, __ATOMIC_RELAXED, __HIP_MEMORY_SCOPE_AGENT); }
__device__ __forceinline__ unsigned xb_xcc_id() { return (unsigned)__builtin_amdgcn_s_getreg((3 << 11) | 20) & 0xFu; }
#define XB_SPIN(cond, bar) do { unsigned _sp = 0; while (cond) { __builtin_amdgcn_s_sleep(1); \
    if ((++_sp & 255u) == 0u) { if (xb_ld(&(bar)[XB_TMO])) break; if (_sp > XB_SPIN_CAP) { atomicAdd(&(bar)[XB_TMO], 1u); break; } } } } while (0)
struct XcdBarrier { unsigned* bar; unsigned x; volatile LAS unsigned* st; };
__device__ __forceinline__ XcdBarrier xcd_barrier_post(unsigned* bar, volatile LAS unsigned* st) {
    XcdBarrier b; b.bar = bar; b.x = xb_xcc_id(); b.st = st;
    if (threadIdx.x == 0) (void)xb_add(&bar[XB_XCNT(b.x)], 1u);
    return b;
}
__device__ __forceinline__ void xcd_barrier_complete(unsigned* bar, unsigned x, unsigned& nloc, unsigned& nx) {
    const unsigned G = gridDim.x * gridDim.y * gridDim.z;
    unsigned sum, cnt, mine, sp = 0u;
    for (;;) {
        sum = 0u; cnt = 0u; mine = 0u;
#pragma unroll
        for (unsigned j = 0; j < 16; ++j) { const unsigned c = xb_ld(&bar[XB_XCNT(j)]); sum += c; cnt += (c > 0u) ? 1u : 0u; mine = (j == x) ? c : mine; }
        if (sum == G) break;
        __builtin_amdgcn_s_sleep(1);
        if ((++sp & 255u) == 0u) { if (xb_ld(&bar[XB_TMO])) break; if (sp > XB_SPIN_CAP) { atomicAdd(&bar[XB_TMO], 1u); break; } }
    }
    nloc = mine > 0u ? mine : 1u; nx = cnt > 0u ? cnt : 1u;
}
__device__ __forceinline__ void xcd_barrier(const XcdBarrier& b) {
    asm volatile("s_waitcnt vmcnt(0)" ::: "memory");
    __syncthreads();
    if (threadIdx.x == 0) {
        unsigned* bar = b.bar;
        __builtin_amdgcn_s_waitcnt(0);
        unsigned nloc = b.st[0], nx = b.st[1];
        if (nloc == 0u) { xcd_barrier_complete(bar, b.x, nloc, nx); b.st[0] = nloc; b.st[1] = nx; }
        const unsigned old = xb_add(&bar[XB_XSUB(b.x)], 1u);
        const unsigned gen = old / nloc;
        if (old + 1u == (gen + 1u) * nloc) {
            __builtin_amdgcn_fence(__ATOMIC_RELEASE, "agent");
            asm volatile("s_waitcnt vmcnt(0)" ::: "memory");
            const unsigned og = xb_add(&bar[XB_TOP], 1u);
            const unsigned tg = og / nx;
            if (og + 1u == (tg + 1u) * nx) xb_add(&bar[XB_TOPGEN], 1u);
            else XB_SPIN(xb_ld(&bar[XB_TOPGEN]) == tg, bar);
            __builtin_amdgcn_fence(__ATOMIC_ACQUIRE, "agent");
            xb_add(&bar[XB_XGEN(b.x)], 1u);
            asm volatile("s_waitcnt vmcnt(0)" ::: "memory");
        } else {
            XB_SPIN(xb_ld(&bar[XB_XGEN(b.x)]) == gen, bar);
            __builtin_amdgcn_fence(__ATOMIC_ACQUIRE, "agent");
            asm volatile("s_waitcnt vmcnt(0)" ::: "memory");
        }
    }
    __syncthreads();
}

namespace pg8 {
constexpr int BM = 256, BK = 64, HALF = 128, HTB = HALF * BK * 2, STAGE_BYTES = 8 * HTB, NXCD = 8, WGM = 8;
__host__ __device__ __forceinline__ int lds_byte(int r, int c) { const int st = (r >> 4) * 2 + (c >> 5), rr = r & 15, cc = c & 31, ob = rr * 64 + cc * 2; return st * 1024 + (ob ^ (((ob >> 9) & 1) << 5)); }
__host__ __device__ __forceinline__ void stage_rc(int b, int& R, int& C) { const int st = b / 1024, sb = b % 1024, swz = sb ^ (((sb >> 9) & 1) << 5); R = (st >> 1) * 16 + swz / 64; C = (st & 1) * 32 + (swz % 64) / 2; }
__host__ __device__ __forceinline__ int perm32(int rho) { const int n = rho >> 4, i = rho & 15; return 8 * (i >> 2) + 4 * n + (i & 3); }

struct Unit { const char* A; const char* B; int pm, pn, aux, rl; };
struct Gemm { int ldaB, ldbB, KB; int sw, sa; unsigned* dummy; };

struct DenseSched {
    const char* A; const char* B; size_t tA, tB; int nM, nN, nwg, G, c;
    __device__ __forceinline__ void init(const void* A_, int ldaB, const void* B_, int ldbB, int M, int N, int G_, int c_) { A = (const char*)A_; B = (const char*)B_; tA = (size_t)BM * ldaB; tB = (size_t)BM * ldbB; nM = M / BM; nN = N / BM; nwg = nM * nN; G = G_; c = c_; }
    __device__ __forceinline__ bool next(int i, Unit& u) const {
        const long L = (long)i * G + c; if (L >= nwg) return false;
        int wgid = (int)L; { const int q = nwg / NXCD, r = nwg % NXCD, xcd = wgid % NXCD, off = wgid / NXCD; wgid = (xcd < r ? xcd * (q + 1) : r * (q + 1) + (xcd - r) * q) + off; }
        const int nig = WGM * nN, gid = wgid / nig, fm = gid * WGM, gsz = (nM - fm) < WGM ? (nM - fm) : WGM;
        u.pm = fm + ((wgid % nig) % gsz); u.pn = (wgid % nig) / gsz; u.aux = 0; u.rl = 0;
        u.A = A + (size_t)u.pm * tA; u.B = B + (size_t)u.pn * tB; return true;
    }
};
struct MoeSched {
    const char* A; const char* B; size_t tA, tB, eB; int NT, G, c; const LAS int* ucum; const LAS int* rb0; bool gather;
    __device__ __forceinline__ bool next(int i, Unit& u) const {
        const int nwg = __builtin_amdgcn_readfirstlane(ucum[NE]); const long L = (long)i * G + c; if (L >= nwg) return false;
        int wgid = (int)L; { const int q = nwg / NXCD, r = nwg % NXCD, xcd = wgid % NXCD, off = wgid / NXCD; wgid = (xcd < r ? xcd * (q + 1) : r * (q + 1) + (xcd - r) * q) + off; }
        int e = 0;
        for (int j = 1; j < NE; ++j) e = (wgid >= ucum[j]) ? j : e;
        e = __builtin_amdgcn_readfirstlane(e);
        const int local = wgid - __builtin_amdgcn_readfirstlane(ucum[e]); const int rb = local / NT, pn = local - rb * NT;
        u.pm = __builtin_amdgcn_readfirstlane(rb0[e]) + rb; u.pn = pn; u.aux = e; u.rl = rb;
        u.A = gather ? A : A + (size_t)u.pm * tA; u.B = B + (size_t)e * eB + (size_t)pn * tB; return true;
    }
};

template <class Epi, class Sched, bool ALIGN_EPI, bool F8 = false, bool GATHER = false>
__device__ __forceinline__ void gemm_phase(LAS unsigned char* lds, const Gemm g, const Sched& S, const Epi& E, int wave_in, const LAS unsigned short* rowlist = nullptr) {
    int wid = wave_in; asm volatile("" : "+s"(wid)); int lane = (int)__builtin_amdgcn_mbcnt_hi(~0u, __builtin_amdgcn_mbcnt_lo(~0u, 0u)); asm volatile("" : "+v"(lane)); const int tid = wid * 64 + lane;
    const int wr = wid >> 2, wc = wid & 3, fr = lane & 15, fq = lane >> 4;
    const int nt = g.KB / (BK * 2);
    unsigned voffA[2], voffB[2]; unsigned cv0[2], cv1[2], nv0[2], nv1[2]; int gR[2], gC[2];
#pragma unroll
    for (int i = 0; i < 2; ++i) { int R, C; stage_rc(tid * 16 + i * 8192, R, C); const int Rb = (R & ~31) + perm32(R & 31); gR[i] = R; gC[i] = C * 2;
        voffA[i] = (unsigned)(R * g.ldaB + C * 2); voffB[i] = (unsigned)(Rb * g.ldbB + C * 2); cv0[i] = cv1[i] = nv0[i] = nv1[i] = 0u; }
#define PG8_ROWS(dst0, dst1, ui_) do { _Pragma("unroll") for (int _i = 0; _i < 2; ++_i) { \
        dst0[_i] = (unsigned)rowlist[(ui_) * 256 + gR[_i]] * (unsigned)g.ldaB + (unsigned)gC[_i]; dst1[_i] = (unsigned)rowlist[(ui_) * 256 + 128 + gR[_i]] * (unsigned)g.ldaB + (unsigned)gC[_i]; } } while (0)
    const size_t kstep = (size_t)(BK * 2);
    const size_t hA = GATHER ? 0 : (size_t)HALF * g.ldaB, hB = (size_t)HALF * g.ldbB;
    const unsigned ldsw = (unsigned)wid * 1024u; const unsigned ldsbase = (unsigned)(uintptr_t)lds;
    const int aoff = lds_byte(wr * 64 + fr, fq * 8), boff = lds_byte(wc * 32 + fr, fq * 8);
#define PG8_SA(b, h) (((b) * 2 + (h)) * HTB)
#define PG8_SB(b, h) ((4 + (b) * 2 + (h)) * HTB)
#define PG8_STAGE(bufoff, gbase, voff) do { if constexpr (F8) { unsigned long long _gb = (unsigned long long)(gbase); asm volatile("" : "+s"(_gb)); _Pragma("unroll") for (int _i = 0; _i < 2; ++_i) \
        __builtin_amdgcn_global_load_lds((const GAS unsigned*)(_gb + (voff)[_i]), (LAS unsigned*)(lds + (bufoff) + ldsw + _i * 8192), 16, 0, 0); } else { \
        const char* _gb = (const char*)(gbase); const unsigned _la = ldsbase + (unsigned)(bufoff) + ldsw; \
        asm volatile("s_mov_b32 m0, %2\n\ts_nop 0\n\tglobal_load_lds_dwordx4 %0, %1" :: "v"((voff)[0]), "s"(_gb), "s"(_la) : "memory", "m0"); \
        asm volatile("s_mov_b32 m0, %2\n\ts_nop 0\n\tglobal_load_lds_dwordx4 %0, %1" :: "v"((voff)[1]), "s"(_gb), "s"(_la + 8192u) : "memory", "m0"); } } while (0)
#define PG8_LDA(dst, b, h) do { _Pragma("unroll") for (int m = 0; m < 4; ++m) _Pragma("unroll") for (int k = 0; k < 2; ++k) dst[m][k] = *(const LAS bf16x8*)(lds + PG8_SA(b, h) + aoff + m * 2048 + k * 1024); } while (0)
#define PG8_LDB(dst, b, h) do { _Pragma("unroll") for (int n = 0; n < 2; ++n) _Pragma("unroll") for (int k = 0; k < 2; ++k) dst[n][k] = *(const LAS bf16x8*)(lds + PG8_SB(b, h) + boff + n * 2048 + k * 1024); } while (0)
#define PG8_MMA(ai, bj, At, Bt) do { __builtin_amdgcn_s_setprio(1); _Pragma("unroll") for (int m = 0; m < 4; ++m) _Pragma("unroll") for (int n = 0; n < 2; ++n) { \
        if constexpr (F8) { const v8i w8_ = __builtin_shufflevector(__builtin_bit_cast(v4i, Bt[n][0]), __builtin_bit_cast(v4i, Bt[n][1]), 0, 1, 2, 3, 4, 5, 6, 7); \
            const v8i a8_ = __builtin_shufflevector(__builtin_bit_cast(v4i, At[m][0]), __builtin_bit_cast(v4i, At[m][1]), 0, 1, 2, 3, 4, 5, 6, 7); \
            asm volatile("v_mfma_scale_f32_16x16x128_f8f6f4 %0, %1, %2, %0, %3, %4 op_sel_hi:[0,0,0]" : "+v"(acc[ai][bj][m][n]) : "v"(w8_), "v"(a8_), "v"(sw_), "v"(sa_)); } \
        else { _Pragma("unroll") for (int k = 0; k < 2; ++k) acc[ai][bj][m][n] = __builtin_amdgcn_mfma_f32_16x16x32_bf16(Bt[n][k], At[m][k], acc[ai][bj][m][n], 0, 0, 0); } } \
        __builtin_amdgcn_s_setprio(0); } while (0)
#define PG8_MMAZ(ai, bj, At, Bt) do { __builtin_amdgcn_s_setprio(1); _Pragma("unroll") for (int m = 0; m < 4; ++m) _Pragma("unroll") for (int n = 0; n < 2; ++n) { \
        if constexpr (F8) { const v8i w8_ = __builtin_shufflevector(__builtin_bit_cast(v4i, Bt[n][0]), __builtin_bit_cast(v4i, Bt[n][1]), 0, 1, 2, 3, 4, 5, 6, 7); \
            const v8i a8_ = __builtin_shufflevector(__builtin_bit_cast(v4i, At[m][0]), __builtin_bit_cast(v4i, At[m][1]), 0, 1, 2, 3, 4, 5, 6, 7); \
            asm volatile("v_mfma_scale_f32_16x16x128_f8f6f4 %0, %1, %2, 0, %3, %4 op_sel_hi:[0,0,0]" : "=&v"(acc[ai][bj][m][n]) : "v"(w8_), "v"(a8_), "v"(sw_), "v"(sa_)); } \
        else { acc[ai][bj][m][n] = __builtin_amdgcn_mfma_f32_16x16x32_bf16(Bt[n][0], At[m][0], (f32x4){0.f, 0.f, 0.f, 0.f}, 0, 0, 0); \
               acc[ai][bj][m][n] = __builtin_amdgcn_mfma_f32_16x16x32_bf16(Bt[n][1], At[m][1], acc[ai][bj][m][n], 0, 0, 0); } } \
        __builtin_amdgcn_s_setprio(0); } while (0)
#define PG8_WAIT_V(n) asm volatile("s_waitcnt vmcnt(" #n ")" ::: "memory")
#define PG8_WAIT_L(n) asm volatile("s_waitcnt lgkmcnt(" #n ")" ::: "memory")
#define PG8_BAR __builtin_amdgcn_s_barrier()
#define PG8_SCHED __builtin_amdgcn_sched_barrier(0)
    Unit cur, nxt; int ui = 0;
    if (!S.next(0, cur)) return;
    const int sw_ = g.sw, sa_ = g.sa; (void)sw_; (void)sa_;
    f32x4 acc[2][2][4][2];
    bf16x8 At[4][2], B0[2][2], B1[2][2];
    const char* cA = cur.A; const char* cB = cur.B;
    if constexpr (GATHER) { PG8_ROWS(cv0, cv1, 0); } else { cv0[0] = cv1[0] = voffA[0]; cv0[1] = cv1[1] = voffA[1]; }
    PG8_STAGE(PG8_SB(0, 0), cB, voffB); PG8_STAGE(PG8_SB(0, 1), cB + hB, voffB); PG8_STAGE(PG8_SA(0, 0), cA, cv0); PG8_STAGE(PG8_SA(0, 1), cA + hA, cv1);
    if (wr == 1) PG8_BAR;
    PG8_WAIT_V(2); PG8_BAR;
    PG8_STAGE(PG8_SB(1, 0), cB + kstep, voffB); PG8_STAGE(PG8_SA(1, 0), cA + kstep, cv0); PG8_STAGE(PG8_SB(1, 1), cB + hB + kstep, voffB);
    PG8_WAIT_V(6); PG8_BAR;
    { const unsigned* dp_ = g.dummy + wid * 64 + lane; const unsigned z_ = 0u;
#pragma unroll
      for (int i_ = 0; i_ < Epi::NST; ++i_) asm volatile("global_store_dword %0, %1, off" :: "v"(dp_), "v"(z_) : "memory"); }
    for (;;) {
        const bool has_next = S.next(ui + 1, nxt);
        const char* nA = has_next ? nxt.A : cA; const char* nB = has_next ? nxt.B : cB;
        if constexpr (GATHER) { if (has_next) { PG8_ROWS(nv0, nv1, ui + 1); } else { nv0[0] = cv0[0]; nv0[1] = cv0[1]; nv1[0] = cv1[0]; nv1[1] = cv1[1]; } }
        else { nv0[0] = nv1[0] = voffA[0]; nv0[1] = nv1[1] = voffA[1]; }
#define PG8_KITER(t_, W12, MMA1) do { const int t = (t_); \
            const bool last = (t == nt - 2); \
            const char* a1 = cA + (size_t)(t + 1) * kstep; \
            const char* a2 = last ? nA : cA + (size_t)(t + 2) * kstep; const char* b2 = last ? nB : cB + (size_t)(t + 2) * kstep; \
            const char* a3 = a2 + kstep; const char* b3 = b2 + kstep; \
            unsigned s0[2], s1[2]; \
            if constexpr (GATHER) { s0[0] = last ? nv0[0] : cv0[0]; s0[1] = last ? nv0[1] : cv0[1]; s1[0] = last ? nv1[0] : cv1[0]; s1[1] = last ? nv1[1] : cv1[1]; } \
            else { s0[0] = s1[0] = voffA[0]; s0[1] = s1[1] = voffA[1]; } \
            PG8_LDB(B0, 0, 0); PG8_LDB(B1, 0, 1); PG8_SCHED; PG8_LDA(At, 0, 0); PG8_STAGE(PG8_SA(1, 1), a1 + hA, cv1); \
            W12; PG8_WAIT_L(0); PG8_BAR; MMA1(0, 0, At, B0); MMA1(0, 1, At, B1); PG8_BAR; PG8_SCHED; \
            PG8_LDA(At, 0, 1); PG8_STAGE(PG8_SB(0, 0), b2, voffB); PG8_STAGE(PG8_SB(0, 1), b2 + hB, voffB); PG8_STAGE(PG8_SA(0, 0), a2, s0); \
            W12; PG8_WAIT_L(0); PG8_BAR; MMA1(1, 0, At, B0); MMA1(1, 1, At, B1); PG8_BAR; PG8_SCHED; \
            PG8_LDB(B0, 1, 0); PG8_LDB(B1, 1, 1); PG8_SCHED; PG8_LDA(At, 1, 0); PG8_STAGE(PG8_SA(0, 1), a2 + hA, s1); \
            PG8_WAIT_V(8); PG8_WAIT_L(0); PG8_BAR; PG8_MMA(0, 0, At, B0); PG8_MMA(0, 1, At, B1); PG8_BAR; PG8_SCHED; \
            PG8_LDA(At, 1, 1); PG8_STAGE(PG8_SB(1, 0), b3, voffB); PG8_STAGE(PG8_SB(1, 1), b3 + hB, voffB); PG8_STAGE(PG8_SA(1, 0), a3, s0); \
            PG8_WAIT_V(8); PG8_WAIT_L(0); PG8_BAR; PG8_MMA(1, 0, At, B0); PG8_MMA(1, 1, At, B1); PG8_BAR; PG8_SCHED; } while (0)
        PG8_KITER(0, asm volatile("s_waitcnt vmcnt(%0)" :: "n"(8 + Epi::NST) : "memory"), PG8_MMAZ);
        for (int t2 = 2; t2 < nt; t2 += 2) PG8_KITER(t2, PG8_WAIT_V(8), PG8_MMA);
#undef PG8_KITER
        if constexpr (ALIGN_EPI) { if (wr == 0) PG8_BAR; }
        if constexpr (F8) asm volatile("s_nop 15\n\ts_nop 15" ::: "memory");
        { int fr_ = fr, fq_ = fq, wr_ = wr, wc_ = wc; asm volatile("" : "+v"(fr_), "+v"(fq_), "+s"(wr_), "+s"(wc_)); E(acc, cur, wr_, wc_, fr_, fq_); }
        if (!has_next) break;
        cur = nxt; cA = nA; cB = nB; ++ui; cv0[0] = nv0[0]; cv0[1] = nv0[1]; cv1[0] = nv1[0]; cv1[1] = nv1[1];
        if constexpr (ALIGN_EPI) { if (wr == 1) PG8_BAR; }
    }
    PG8_WAIT_V(0);
    if constexpr (!ALIGN_EPI) { if (wr == 0) PG8_BAR; }
    PG8_BAR;
#undef PG8_SA
#undef PG8_SB
#undef PG8_STAGE
#undef PG8_ROWS
#undef PG8_LDA
#undef PG8_LDB
#undef PG8_MMA
#undef PG8_MMAZ
#undef PG8_WAIT_V
#undef PG8_WAIT_L
#undef PG8_BAR
#undef PG8_SCHED
}

#define EPI_ROW(u, ai, m) ((u).pm * 256 + (ai) * 128 + wr * 64 + (m) * 16 + fr)
#define EPI_COL(bj) ((bj) * 128 + wc * 32 + 8 * fq)
typedef f32x4 Acc[2][2][4][2];
#define EPI_FENCE() asm volatile("" ::: "memory")

#define LOADS_DONE() asm volatile("" ::: "memory")
struct EpiZ {
    static constexpr int NST = 16;
    const float* rsp; float* rspq; float* rspkv; bf16_t* zm; bf16_t* zd; bf16_t* gt; bf16_t* kr; const float* cosT; const float* sinT; unsigned* krmx;
    __device__ __forceinline__ void operator()(const Acc& acc, const Unit& u, int wr, int wc, int fr, int fq) const {
        const int pn = u.pn; float krq = 0.f; float kdq[2] = {0.f, 0.f};
        float rstd[2][4];
#pragma unroll
        for (int ai = 0; ai < 2; ++ai)
#pragma unroll
            for (int m = 0; m < 4; ++m) rstd[ai][m] = rsp[EPI_ROW(u, ai, m)];
#pragma unroll
        for (int ai = 0; ai < 2; ++ai)
#pragma unroll
            for (int m = 0; m < 4; ++m) rstd[ai][m] = __builtin_amdgcn_rsqf(rstd[ai][m] * (1.0f / DM) + EPS);
        const bool ropew = (pn == 2 && wc == 0);
        LOADS_DONE();
#pragma unroll
        for (int ai = 0; ai < 2; ++ai)
#pragma unroll
            for (int m = 0; m < 4; ++m) {
                const int row = EPI_ROW(u, ai, m);
                const float rs_ = rstd[ai][m];
                if (pn < 3) {
                    float ss = 0.f;
#pragma unroll
                    for (int bj = 0; bj < 2; ++bj) {
                        const f32x4 v0 = acc[ai][bj][m][0] * rs_, v1 = acc[ai][bj][m][1] * rs_;
                        *(u32x4*)(zm + (size_t)row * ZM_LD + pn * 256 + EPI_COL(bj)) = pack8(v0, v1);
                        if (pn != 2 || bj == 0) ss += (v0[0] * v0[0] + v0[1] * v0[1]) + (v0[2] * v0[2] + v0[3] * v0[3]) + (v1[0] * v1[0] + v1[1] * v1[1]) + (v1[2] * v1[2] + v1[3] * v1[3]);
                        if (ropew && bj == 1) {
                            const int pos = row & (SEQ - 1); const f32x4 cs = *(const f32x4*)(cosT + pos * 16 + 4 * fq), sn = *(const f32x4*)(sinT + pos * 16 + 4 * fq);
                            const f32x4 o0 = v0 * cs - v1 * sn, o1 = v0 * sn + v1 * cs;
                            const u32x4 pk_ = pack8(o0, o1); *(u32x4*)(kr + (size_t)row * 32 + 8 * fq) = pk_;
                            f32x4 w0, w1; unpack8(pk_, w0, w1); float q_ = (w0[0] * w0[0] + w0[1] * w0[1]) + (w0[2] * w0[2] + w0[3] * w0[3]) + (w1[0] * w1[0] + w1[1] * w1[1]) + (w1[2] * w1[2] + w1[3] * w1[3]);
                            q_ += sx<16>(q_); q_ = sum32(q_); krq = fmaxf(krq, q_);
                        }
                    }
                    ss += sx<16>(ss); ss = sum32(ss);
                    if (fq == 0) { if (pn == 0) rspkv[(size_t)row * 4 + wc] = ss; else rspq[(size_t)row * 8 + (pn - 1) * 4 + wc] = ss; }
                } else if (pn < 12) {
                    const int j = pn - 3; const float sc = rs_ * ((j % 3) == 0 ? C2_DIL : 1.0f);
#pragma unroll
                    for (int bj = 0; bj < 2; ++bj) { const u32x4 pk_ = pack8(acc[ai][bj][m][0] * sc, acc[ai][bj][m][1] * sc); *(u32x4*)(zd + (size_t)row * ZD_LD + j * 256 + EPI_COL(bj)) = pk_;
                        if ((j % 3) == 1) { f32x4 w0, w1; unpack8(pk_, w0, w1); float q_ = (w0[0] * w0[0] + w0[1] * w0[1]) + (w0[2] * w0[2] + w0[3] * w0[3]) + (w1[0] * w1[0] + w1[1] * w1[1]) + (w1[2] * w1[2] + w1[3] * w1[3]);
                            q_ += sx<16>(q_); q_ = sum32(q_); kdq[bj] = fmaxf(kdq[bj], q_); } }
                } else {
                    const int j = pn - 12;
#pragma unroll
                    for (int bj = 0; bj < 2; ++bj) { f32x4 v0 = acc[ai][bj][m][0] * rs_, v1 = acc[ai][bj][m][1] * rs_;
#pragma unroll
                        for (int i = 0; i < 4; ++i) { v0[i] = fsigmoid(v0[i]); v1[i] = fsigmoid(v1[i]); }
                        *(u32x4*)(gt + (size_t)row * GT_LD + j * 256 + EPI_COL(bj)) = pack8(v0, v1); }
                }
            }
        if (pn >= 3 && pn < 12 && ((pn - 3) % 3) == 1) {
#pragma unroll
            for (int bj = 0; bj < 2; ++bj) { float q_ = kdq[bj]; q_ = fmaxf(q_, sx<1>(q_)); q_ = fmaxf(q_, sx<2>(q_)); q_ = fmaxf(q_, sx<4>(q_)); q_ = fmaxf(q_, sx<8>(q_));
                if ((fr | fq) == 0) (void)__hip_atomic_fetch_max((GAS unsigned*)krmx + 16 + (((u.pm * 256 / SEQ) * 3 + (pn - 3) / 3) * 4 + 2 * bj + (wc >> 1)) * 2 + (wc & 1), __float_as_uint(q_), __ATOMIC_RELAXED, __HIP_MEMORY_SCOPE_AGENT); } }
        if (ropew) {
            { krq = fmaxf(krq, sx<1>(krq)); krq = fmaxf(krq, sx<2>(krq)); krq = fmaxf(krq, sx<4>(krq)); krq = fmaxf(krq, sx<8>(krq)); }
            if ((fr | fq) == 0) (void)__hip_atomic_fetch_max((GAS unsigned*)krmx + (u.pm * 256 / SEQ), __float_as_uint(krq), __ATOMIC_RELAXED, __HIP_MEMORY_SCOPE_AGENT); }
    }
};
template <bool KMAX = false, bool OUT8 = false> struct EpiGen {
    static constexpr int NST = 16;
    bf16_t* out; int ldo; const float* rs; int rsn; float rsdiv; float cscale; const bf16_t* mul; int ldm; const bf16_t* add; int ldadd; unsigned* kmx;
    __device__ __forceinline__ void operator()(const Acc& acc, const Unit& u, int wr, int wc, int fr, int fq) const {
        float kq[2] = {0.f, 0.f};
#pragma unroll
        for (int ai = 0; ai < 2; ++ai) {
            f32x4 r0[4], r1[4]; u32x4 mv[4][2], av[4][2];
#pragma unroll
            for (int m = 0; m < 4; ++m) { const int row = EPI_ROW(u, ai, m);
                if (rs) { r0[m] = *(const f32x4*)(rs + (size_t)row * 4 * rsn); if (rsn == 2) r1[m] = *(const f32x4*)(rs + (size_t)row * 8 + 4); }
#pragma unroll
                for (int bj = 0; bj < 2; ++bj) { const int col = u.pn * 256 + EPI_COL(bj);
                    if (mul) mv[m][bj] = *(const u32x4*)(mul + (size_t)row * ldm + col);
                    if (add) av[m][bj] = *(const u32x4*)(add + (size_t)row * ldadd + col); } }
            LOADS_DONE();
#pragma unroll
            for (int m = 0; m < 4; ++m) { const int row = EPI_ROW(u, ai, m);
                float sc = 1.0f; if (rs) { float t = (r0[m][0] + r0[m][1]) + (r0[m][2] + r0[m][3]); if (rsn == 2) t += (r1[m][0] + r1[m][1]) + (r1[m][2] + r1[m][3]); sc = __builtin_amdgcn_rsqf(t * rsdiv + EPS) * cscale; }
#pragma unroll
                for (int bj = 0; bj < 2; ++bj) { const int col = u.pn * 256 + EPI_COL(bj);
                    f32x4 v0 = acc[ai][bj][m][0] * sc, v1 = acc[ai][bj][m][1] * sc;
                    if (mul) { f32x4 g0, g1; unpack8(mv[m][bj], g0, g1); v0 = v0 * g0; v1 = v1 * g1; }
                    if (add) { f32x4 a0, a1; unpack8(av[m][bj], a0, a1); v0 = v0 + a0; v1 = v1 + a1; }
                    u32x4 pk_ = {0u, 0u, 0u, 0u};
                    if constexpr (OUT8) { u32x2 w8; w8.x = pk4_fp8(8.f * v0[0], 8.f * v0[1], 8.f * v0[2], 8.f * v0[3]); w8.y = pk4_fp8(8.f * v1[0], 8.f * v1[1], 8.f * v1[2], 8.f * v1[3]); *(u32x2*)((unsigned char*)out + (size_t)row * ldo + col) = w8; }
                    else { pk_ = pack8(v0, v1); *(u32x4*)(out + (size_t)row * ldo + col) = pk_; }
                    if (KMAX) { f32x4 w0, w1; unpack8(pk_, w0, w1);
                        float q_ = (w0[0] * w0[0] + w0[1] * w0[1]) + (w0[2] * w0[2] + w0[3] * w0[3]) + (w1[0] * w1[0] + w1[1] * w1[1]) + (w1[2] * w1[2] + w1[3] * w1[3]);
                        q_ += sx<16>(q_); q_ = sum32(q_); kq[bj] = fmaxf(kq[bj], q_); } } }
            LOADS_DONE();
        }
        if (KMAX) { if (wc < 2) {
#pragma unroll
            for (int bj = 0; bj < 2; ++bj) { float q_ = kq[bj];
                { q_ = fmaxf(q_, sx<1>(q_)); q_ = fmaxf(q_, sx<2>(q_)); q_ = fmaxf(q_, sx<4>(q_)); q_ = fmaxf(q_, sx<8>(q_)); }
                if ((fr | fq) == 0) (void)__hip_atomic_fetch_max((GAS unsigned*)kmx + ((u.pm * 256 / SEQ) * NH + u.pn * 2 + bj) * 2 + wc, __float_as_uint(q_), __ATOMIC_RELAXED, __HIP_MEMORY_SCOPE_AGENT); } } }
    }
};
template <bool GATED> struct EpiRes {
    static constexpr int NST = 16;
    const bf16_t* xbin; bf16_t* xo16; unsigned char* xo8; float* rspn; const float* rs; const bf16_t* pp;
    __device__ __forceinline__ void operator()(const Acc& acc, const Unit& u, int wr, int wc, int fr, int fq) const {
        constexpr int MB = GATED ? 2 : 4;
#pragma unroll
        for (int ai = 0; ai < 2; ++ai)
#pragma unroll
        for (int m0 = 0; m0 < 4; m0 += MB) {
            u32x4 bb[MB][2], pv[MB][2]; float rv[MB];
#pragma unroll
            for (int mi = 0; mi < MB; ++mi) { const int row = EPI_ROW(u, ai, m0 + mi);
                if (GATED) rv[mi] = rs[row];
#pragma unroll
                for (int bj = 0; bj < 2; ++bj) { const size_t o = (size_t)row * DM + u.pn * 256 + EPI_COL(bj);
                    bb[mi][bj] = *(const u32x4*)(xbin + o);
                    if (GATED) pv[mi][bj] = *(const u32x4*)(pp + o); } }
            LOADS_DONE();
#pragma unroll
            for (int mi = 0; mi < MB; ++mi) { const int m = m0 + mi; const int row = EPI_ROW(u, ai, m);
                float sc = 1.0f; if (GATED) sc = __builtin_amdgcn_rsqf(rv[mi] * (1.0f / DM) + EPS);
                float ss = 0.f;
#pragma unroll
                for (int bj = 0; bj < 2; ++bj) { const size_t o = (size_t)row * DM + u.pn * 256 + EPI_COL(bj);
                    f32x4 v0 = acc[ai][bj][m][0], v1 = acc[ai][bj][m][1];
                    if (GATED) { f32x4 p0, p1; unpack8(pv[mi][bj], p0, p1);
#pragma unroll
                        for (int i = 0; i < 4; ++i) { v0[i] = fsigmoid(v0[i] * sc) * p0[i]; v1[i] = fsigmoid(v1[i] * sc) * p1[i]; } }
                    { f32x4 b0, b1; unpack8(bb[mi][bj], b0, b1); v0 = v0 + b0; v1 = v1 + b1; }
                    *(u32x4*)(xo16 + o) = pack8(v0, v1);
                    if (xo8) { u32x2 w8; w8.x = pk4_fp8(4.f * v0[0], 4.f * v0[1], 4.f * v0[2], 4.f * v0[3]); w8.y = pk4_fp8(4.f * v1[0], 4.f * v1[1], 4.f * v1[2], 4.f * v1[3]); *(u32x2*)(xo8 + o) = w8; }
                    ss += (v0[0] * v0[0] + v0[1] * v0[1]) + (v0[2] * v0[2] + v0[3] * v0[3]) + (v1[0] * v1[0] + v1[1] * v1[1]) + (v1[2] * v1[2] + v1[3] * v1[3]); }
                ss += sx<16>(ss); ss = sum32(ss);
                if (fq == 0) rspn[(size_t)row * 16 + u.pn * 4 + wc] = ss; }
            LOADS_DONE();
        }
    }
};
struct EpiSwiglu {
    static constexpr int NST = 8;
    unsigned char* hm; const float* bg; const float* bu;
    __device__ __forceinline__ void operator()(const Acc& acc, const Unit& u, int wr, int wc, int fr, int fq) const {
        const int hc = u.pn * 128 + wc * 32 + 8 * fq;
        const f32x4 bg0 = *(const f32x4*)(bg + u.aux * DE + hc), bg1 = *(const f32x4*)(bg + u.aux * DE + hc + 4);
        const f32x4 bu0 = *(const f32x4*)(bu + u.aux * DE + hc), bu1 = *(const f32x4*)(bu + u.aux * DE + hc + 4);
        LOADS_DONE();
#pragma unroll
        for (int ai = 0; ai < 2; ++ai)
#pragma unroll
            for (int m = 0; m < 4; ++m) {
                const int row = EPI_ROW(u, ai, m);
                f32x4 g0 = acc[ai][0][m][0] + bg0, g1 = acc[ai][0][m][1] + bg1, u0 = acc[ai][1][m][0] + bu0, u1 = acc[ai][1][m][1] + bu1;
#pragma unroll
                for (int i = 0; i < 4; ++i) { g0[i] = fminf(g0[i], 7.0f); g1[i] = fminf(g1[i], 7.0f); }
                f32x4 e0 = g0 * (-1.702f * LOG2E), e1 = g1 * (-1.702f * LOG2E);
#pragma unroll
                for (int i = 0; i < 4; ++i) { e0[i] = __builtin_amdgcn_exp2f(e0[i]); e1[i] = __builtin_amdgcn_exp2f(e1[i]); }
                e0 = e0 + 1.0f; e1 = e1 + 1.0f;
#pragma unroll
                for (int i = 0; i < 4; ++i) { e0[i] = __builtin_amdgcn_rcpf(e0[i]); e1[i] = __builtin_amdgcn_rcpf(e1[i]); u0[i] = __builtin_amdgcn_fmed3f(u0[i], -7.0f, 7.0f); u1[i] = __builtin_amdgcn_fmed3f(u1[i], -7.0f, 7.0f); }
                g0 = (g0 * e0) * (u0 * 4.0f + 4.0f); g1 = (g1 * e1) * (u1 * 4.0f + 4.0f);
                u32x2 w; w.x = pk4_fp8_nc(g0[0], g0[1], g0[2], g0[3]); w.y = pk4_fp8_nc(g1[0], g1[1], g1[2], g1[3]);
                *(u32x2*)(hm + (size_t)row * DE + hc) = w;
            }
    }
};
struct EpiDown {
    static constexpr int NST = 16;
    unsigned char* y; const float* wl; const float* bd;
    __device__ __forceinline__ void operator()(const Acc& acc, const Unit& u, int wr, int wc, int fr, int fq) const {
        f32x4 b0[2], b1[2]; float w[2][4];
#pragma unroll
        for (int bj = 0; bj < 2; ++bj) { const int col = u.pn * 256 + EPI_COL(bj); b0[bj] = *(const f32x4*)(bd + u.aux * DM + col); b1[bj] = *(const f32x4*)(bd + u.aux * DM + col + 4); }
#pragma unroll
        for (int ai = 0; ai < 2; ++ai)
#pragma unroll
            for (int m = 0; m < 4; ++m) w[ai][m] = 8.0f * wl[(size_t)u.aux * 32768 + u.rl * 256 + ai * 128 + wr * 64 + m * 16 + fr];
        LOADS_DONE();
#pragma unroll
        for (int ai = 0; ai < 2; ++ai)
#pragma unroll
            for (int m = 0; m < 4; ++m) {
                const int row = EPI_ROW(u, ai, m);
#pragma unroll
                for (int bj = 0; bj < 2; ++bj) {
                    const int col = u.pn * 256 + EPI_COL(bj);
                    const f32x4 y0 = (acc[ai][bj][m][0] + b0[bj]) * w[ai][m], y1 = (acc[ai][bj][m][1] + b1[bj]) * w[ai][m];
                    u32x2 w8; w8.x = pk4_fp8(y0[0], y0[1], y0[2], y0[3]); w8.y = pk4_fp8(y1[0], y1[1], y1[2], y1[3]); *(u32x2*)(y + (size_t)row * DM + col) = w8;
                }
            }
    }
};
}

namespace att {
constexpr int KVBLK = 64;
constexpr int SHM_K = 64 * 256, SHM_V = 64 * 64 * 2;
constexpr int OFF_K = 0, OFF_V = 2 * SHM_K, OFF_WS = 2 * SHM_K + 2 * SHM_V, ATT_LDS = OFF_WS + 8 * 256;
constexpr float THR = 8.0f;
#define KSWZ(row, colB) ((row) * 256 + ((colB) ^ (((row) & 7) << 4)))
#define SBAR() __builtin_amdgcn_sched_barrier(0)
__device__ __forceinline__ int v_st(int k, int c) { const int kk = k; return ((kk >> 3) * 2 + (c >> 5)) * 512 + ((kk & 7) * 32 + (c & 31)) * 2; }
__device__ __forceinline__ int v_rd_base(int lane) { return ((lane & 3) << 3) | (((lane >> 2) & 3) << 6) | (((lane >> 4) & 1) << 5) | (((lane >> 5) & 1) << 8); }
constexpr int v_rd_off(int d0, int ks, int half) { return d0 * 512 + ks * 2048 + half * 1024; }
template <int OFF> __device__ __forceinline__ s16x4 tr_read(int vb) { s16x4 r; asm volatile("ds_read_b64_tr_b16 %0, %1 offset:%2" : "=&v"(r) : "v"(vb), "i"(OFF) : "memory"); return r; }
template <int D0> __device__ __forceinline__ void pv_one(f32x16& od, int vb, bf16x8 pa0, bf16x8 pa1, bf16x8 pa2, bf16x8 pa3) {
    const s16x4 l0 = tr_read<v_rd_off(D0, 0, 0)>(vb), h0 = tr_read<v_rd_off(D0, 0, 1)>(vb), l1 = tr_read<v_rd_off(D0, 1, 0)>(vb), h1 = tr_read<v_rd_off(D0, 1, 1)>(vb);
    const s16x4 l2 = tr_read<v_rd_off(D0, 2, 0)>(vb), h2 = tr_read<v_rd_off(D0, 2, 1)>(vb), l3 = tr_read<v_rd_off(D0, 3, 0)>(vb), h3 = tr_read<v_rd_off(D0, 3, 1)>(vb);
    asm volatile("s_waitcnt lgkmcnt(0)" ::: "memory"); SBAR();
#define PK(L, H) (bf16x8){L[0], L[1], L[2], L[3], H[0], H[1], H[2], H[3]}
    od = __builtin_amdgcn_mfma_f32_32x32x16_bf16(pa0, PK(l0, h0), od, 0, 0, 0);
    od = __builtin_amdgcn_mfma_f32_32x32x16_bf16(pa1, PK(l1, h1), od, 0, 0, 0);
    od = __builtin_amdgcn_mfma_f32_32x32x16_bf16(pa2, PK(l2, h2), od, 0, 0, 0);
    od = __builtin_amdgcn_mfma_f32_32x32x16_bf16(pa3, PK(l3, h3), od, 0, 0, 0);
#undef PK
}
__device__ __forceinline__ void pv_d0(f32x16* o, int vb, bf16x8 pa0, bf16x8 pa1, bf16x8 pa2, bf16x8 pa3) { pv_one<0>(o[0], vb, pa0, pa1, pa2, pa3); pv_one<1>(o[1], vb, pa0, pa1, pa2, pa3); }
__device__ __forceinline__ void partialSM(f32x16& p0, f32x16& p1, float& m_reg, float& alpha) {
    float pmax = p0[0];
#pragma unroll
    for (int r = 1; r < 16; ++r) pmax = fmaxf(pmax, p0[r]);
#pragma unroll
    for (int r = 0; r < 16; ++r) pmax = fmaxf(pmax, p1[r]);
    { auto rr = __builtin_amdgcn_permlane32_swap(__float_as_uint(pmax), __float_as_uint(pmax), false, false); pmax = fmaxf(__uint_as_float(rr[0]), __uint_as_float(rr[1])); }
    float mn;
    if (__builtin_expect(__all(pmax - m_reg <= THR), 1)) { mn = m_reg; alpha = 1.f; }
    else { mn = fmaxf(m_reg, pmax); alpha = __builtin_amdgcn_exp2f(m_reg - mn); m_reg = mn; }
#pragma unroll
    for (int r = 0; r < 16; ++r) { p0[r] = p0[r] - mn; p1[r] = p1[r] - mn; }
#pragma unroll
    for (int r = 0; r < 16; ++r) p0[r] = __builtin_amdgcn_exp2f(p0[r]);
}
__device__ __forceinline__ void finishSM(f32x16& p0, f32x16& p1, float alpha, float& l_reg, bf16x8& pa0, bf16x8& pa1, bf16x8& pa2, bf16x8& pa3) {
#pragma unroll
    for (int r = 0; r < 16; ++r) p1[r] = __builtin_amdgcn_exp2f(p1[r]);
    float ps = 0;
#pragma unroll
    for (int r = 0; r < 16; ++r) ps += p0[r];
#pragma unroll
    for (int r = 0; r < 16; ++r) ps += p1[r];
    { auto rr = __builtin_amdgcn_permlane32_swap(__float_as_uint(ps), __float_as_uint(ps), false, false); ps = __uint_as_float(rr[0]) + __uint_as_float(rr[1]); }
    l_reg = l_reg * alpha + ps;
#define PK4(P, BASE, OUT) do { unsigned a0 = cvtpk(P[BASE + 0], P[BASE + 1]), a1 = cvtpk(P[BASE + 2], P[BASE + 3]);   \
    unsigned b0 = cvtpk(P[BASE + 4], P[BASE + 5]), b1 = cvtpk(P[BASE + 6], P[BASE + 7]);                              \
    auto r0 = __builtin_amdgcn_permlane32_swap(a0, b0, false, false); auto r1 = __builtin_amdgcn_permlane32_swap(a1, b1, false, false); \
    u32x4 w = {r0[0], r1[0], r0[1], r1[1]}; OUT = __builtin_bit_cast(bf16x8, w); } while (0)
    PK4(p0, 0, pa0); PK4(p0, 8, pa1); PK4(p1, 0, pa2); PK4(p1, 8, pa3);
#undef PK4
}
template <int NQ> __device__ __forceinline__ void qkt_c(f32x16& p0, f32x16& p1, const LAS char* Ks, const bf16x8* qr, int r32, int hi, const f32x16& c0) {
    p0 = c0; p1 = c0;
#pragma unroll
    for (int d0 = 0; d0 < NQ; ++d0) { const int cb = (d0 * 16 + hi * 8) * 2;
        const bf16x8 b0 = *(const LAS bf16x8*)(Ks + KSWZ(r32, cb));
        const bf16x8 b1 = *(const LAS bf16x8*)(Ks + KSWZ(32 + r32, cb));
        p0 = __builtin_amdgcn_mfma_f32_32x32x16_bf16(b0, qr[d0], p0, 0, 0, 0);
        p1 = __builtin_amdgcn_mfma_f32_32x32x16_bf16(b1, qr[d0], p1, 0, 0, 0); }
}
template <int NQ> __device__ __forceinline__ void qkt_c128(f32x16& p0, f32x16& p1, const LAS char* Ks, const bf16x8* qr, int r32, int hi, const f32x16& c0) {
    p0 = c0; p1 = c0;
#pragma unroll
    for (int d0 = 0; d0 < NQ; ++d0) { const int cb = ((d0 * 2 + hi) ^ (r32 & 7)) << 4;
        const bf16x8 b0 = *(const LAS bf16x8*)(Ks + r32 * 128 + cb);
        const bf16x8 b1 = *(const LAS bf16x8*)(Ks + (32 + r32) * 128 + cb);
        p0 = __builtin_amdgcn_mfma_f32_32x32x16_bf16(b0, qr[d0], p0, 0, 0, 0);
        p1 = __builtin_amdgcn_mfma_f32_32x32x16_bf16(b1, qr[d0], p1, 0, 0, 0); }
}
template <int NQ> __device__ __forceinline__ void qkt(f32x16& p0, f32x16& p1, const LAS char* Ks, const bf16x8* qr, int r32, int hi) {
    p0 = f32x16{}; p1 = f32x16{};
#pragma unroll
    for (int d0 = 0; d0 < NQ; ++d0) { const int cb = (d0 * 16 + hi * 8) * 2;
        const bf16x8 b0 = *(const LAS bf16x8*)(Ks + KSWZ(r32, cb));
        const bf16x8 b1 = *(const LAS bf16x8*)(Ks + KSWZ(32 + r32, cb));
        p0 = __builtin_amdgcn_mfma_f32_32x32x16_bf16(b0, qr[d0], p0, 0, 0, 0);
        p1 = __builtin_amdgcn_mfma_f32_32x32x16_bf16(b1, qr[d0], p1, 0, 0, 0); }
}
__device__ __forceinline__ void partialSM_nb(f32x16& p0, f32x16& p1, float& m_reg, float& alpha) {
    float pmax = p0[0];
#pragma unroll
    for (int r = 1; r < 16; ++r) pmax = fmaxf(pmax, p0[r]);
#pragma unroll
    for (int r = 0; r < 16; ++r) pmax = fmaxf(pmax, p1[r]);
    { auto rr = __builtin_amdgcn_permlane32_swap(__float_as_uint(pmax), __float_as_uint(pmax), false, false); pmax = fmaxf(__uint_as_float(rr[0]), __uint_as_float(rr[1])); }
    const bool keep = __all(pmax - m_reg <= THR);
    const float mn = keep ? m_reg : fmaxf(m_reg, pmax);
    alpha = __builtin_amdgcn_exp2f(m_reg - mn);
    m_reg = mn;
#pragma unroll
    for (int r = 0; r < 16; ++r) { p0[r] = p0[r] - mn; p1[r] = p1[r] - mn; }
#pragma unroll
    for (int r = 0; r < 16; ++r) p0[r] = __builtin_amdgcn_exp2f(p0[r]);
}
__device__ __forceinline__ void pv_all(f32x16* o, int vb, bf16x8 pa0, bf16x8 pa1, bf16x8 pa2, bf16x8 pa3, s16x4 (&l)[8], s16x4 (&h)[8]) {
#define PK(L, H) (bf16x8){L[0], L[1], L[2], L[3], H[0], H[1], H[2], H[3]}
    o[0] = __builtin_amdgcn_mfma_f32_32x32x16_bf16(pa0, PK(l[0], h[0]), o[0], 0, 0, 0); o[1] = __builtin_amdgcn_mfma_f32_32x32x16_bf16(pa0, PK(l[4], h[4]), o[1], 0, 0, 0);
    o[0] = __builtin_amdgcn_mfma_f32_32x32x16_bf16(pa1, PK(l[1], h[1]), o[0], 0, 0, 0); o[1] = __builtin_amdgcn_mfma_f32_32x32x16_bf16(pa1, PK(l[5], h[5]), o[1], 0, 0, 0);
    o[0] = __builtin_amdgcn_mfma_f32_32x32x16_bf16(pa2, PK(l[2], h[2]), o[0], 0, 0, 0); o[1] = __builtin_amdgcn_mfma_f32_32x32x16_bf16(pa2, PK(l[6], h[6]), o[1], 0, 0, 0);
    o[0] = __builtin_amdgcn_mfma_f32_32x32x16_bf16(pa3, PK(l[3], h[3]), o[0], 0, 0, 0); o[1] = __builtin_amdgcn_mfma_f32_32x32x16_bf16(pa3, PK(l[7], h[7]), o[1], 0, 0, 0);
#undef PK
}
__device__ __forceinline__ void pv_reads(int vb, s16x4 (&l)[8], s16x4 (&h)[8]) {
    l[0] = tr_read<v_rd_off(0, 0, 0)>(vb); h[0] = tr_read<v_rd_off(0, 0, 1)>(vb); l[1] = tr_read<v_rd_off(0, 1, 0)>(vb); h[1] = tr_read<v_rd_off(0, 1, 1)>(vb);
    l[2] = tr_read<v_rd_off(0, 2, 0)>(vb); h[2] = tr_read<v_rd_off(0, 2, 1)>(vb); l[3] = tr_read<v_rd_off(0, 3, 0)>(vb); h[3] = tr_read<v_rd_off(0, 3, 1)>(vb);
    l[4] = tr_read<v_rd_off(1, 0, 0)>(vb); h[4] = tr_read<v_rd_off(1, 0, 1)>(vb); l[5] = tr_read<v_rd_off(1, 1, 0)>(vb); h[5] = tr_read<v_rd_off(1, 1, 1)>(vb);
    l[6] = tr_read<v_rd_off(1, 2, 0)>(vb); h[6] = tr_read<v_rd_off(1, 2, 1)>(vb); l[7] = tr_read<v_rd_off(1, 3, 0)>(vb); h[7] = tr_read<v_rd_off(1, 3, 1)>(vb);
    asm volatile("s_waitcnt lgkmcnt(0)" ::: "memory"); SBAR();
}
struct Args {
    const bf16_t* Q; long ldq;
    const bf16_t* K; long ldk;
    const bf16_t* K2; long ldk2;
    const bf16_t* V; long ldv;
    bf16_t* O; long ldo; float* lse; long ldlse;
    const float* cosT; const float* sinT;
    int t0, t1;
    int qoff;
    int tmask;
    float ab;
    float kn;
};
template <int MODE> __device__ __forceinline__ void mask_tile(f32x16& p0, f32x16& p1, int t, int n, int hi, const Args& a) {
    const int base = n + a.qoff - 64 * t - 4 * hi;
    if (MODE == 0) {
#pragma unroll
        for (int r = 0; r < 16; ++r) { const int rel = base - ((r & 3) + 8 * (r >> 2)); if (rel < 0) p0[r] = -INFINITY; if (rel - 32 < 0) p1[r] = -INFINITY; }
    } else {
#pragma unroll
        for (int r = 0; r < 16; ++r) { const int rel = base - ((r & 3) + 8 * (r >> 2)); const int rel1 = rel - 32;
            p0[r] = (rel < 0 || rel > 128) ? -INFINITY : p0[r] - a.ab * (float)rel;
            p1[r] = (rel1 < 0 || rel1 > 128) ? -INFINITY : p1[r] - a.ab * (float)rel1; }
    }
}
template <int MODE> __device__ __forceinline__ void attn_unit(const Args& a, LAS char* lds, int wave_in) {
    constexpr int NQ = MODE == 0 ? 6 : 4;
    int wid = wave_in; asm volatile("" : "+s"(wid)); int lane = (int)__builtin_amdgcn_mbcnt_hi(~0u, __builtin_amdgcn_mbcnt_lo(~0u, 0u)); asm volatile("" : "+v"(lane)); const int tid = wid * 64 + lane;
    const int r32 = lane & 31, hi = lane >> 5;
    LAS char* V_lds = lds + OFF_V; LAS char* K_lds = lds + OFF_K;
    LAS float* ws = (LAS float*)(lds + (MODE == 0 ? 3 * SHM_K + 3 * SHM_V : 12 * 8192)) + wid * 64; LAS float* li_l = ws; LAS float* al_l = ws + 32; (void)al_l;
    float m_reg = -1e30f, l_reg = 0; f32x16 o[2] = {}; bf16x8 qr[NQ];
    const bf16_t* Qw = a.Q + (long)(wid * 32 + r32) * a.ldq + hi * 8;
#pragma unroll
    for (int d0 = 0; d0 < NQ; ++d0) qr[d0] = *(const bf16x8*)(Qw + d0 * 16);
    if (MODE == 0) {
        const int pos = a.qoff + wid * 32 + r32;
#pragma unroll
        for (int d0 = 4; d0 < 6; ++d0) { const int jg = 2 * (d0 - 4) + hi;
            const f32x4 cs = *(const f32x4*)(a.cosT + pos * 16 + 4 * jg), sn = *(const f32x4*)(a.sinT + pos * 16 + 4 * jg);
            f32x4 v0, v1; unpack8(__builtin_bit_cast(u32x4, qr[d0 < NQ ? d0 : 0]), v0, v1);
            const f32x4 o0 = v0 * cs - v1 * sn, o1 = v0 * sn + v1 * cs;
            if (d0 < NQ) qr[d0] = __builtin_bit_cast(bf16x8, pack8(o0, o1)); }
    }
    const int sr = tid >> 4, kc = tid & 15, vr = tid >> 3, vc = tid & 7;
    const int vst = v_st(vr, vc * 8);
    const int vb0 = (int)(uintptr_t)V_lds + v_rd_base(lane);
    const bf16_t* kp0; const bf16_t* kp1; long kstep64; int kst0, kst1;
    if (MODE == 0) { const bool rope = kc >= 8; const int kcc = rope ? ((kc - 8) & 3) : kc;
        kp0 = rope ? a.K2 + (long)sr * a.ldk2 + kcc * 8 : a.K + (long)sr * a.ldk + kcc * 8;
        kp1 = rope ? a.K2 + (long)(sr + 32) * a.ldk2 + kcc * 8 : a.K + (long)(sr + 32) * a.ldk + kcc * 8;
        kstep64 = rope ? 64 * a.ldk2 : 64 * a.ldk; kst0 = KSWZ(sr, kc * 16); kst1 = KSWZ(sr + 32, kc * 16);
    } else { kp0 = a.K + (long)vr * a.ldk + vc * 8; kp1 = kp0; kstep64 = 64 * a.ldk; kst0 = KSWZ(vr, vc * 16); kst1 = kst0; }
    const bf16_t* vp = a.V + (long)vr * a.ldv + vc * 8; const long vstep64 = 64 * a.ldv;
    struct Slot { bf16x8 v, k0, k1; } sl[1];
#define SLOAD(i, t) do { sl[i].v = *(const bf16x8*)(vp + (long)(t) * vstep64); sl[i].k0 = *(const bf16x8*)(kp0 + (long)(t) * kstep64); \
        if (MODE == 0) sl[i].k1 = *(const bf16x8*)(kp1 + (long)(t) * kstep64); } while (0)
#define SWRITE(b, i) do { *(LAS bf16x8*)(V_lds + (b) * SHM_V + vst) = sl[i].v; *(LAS bf16x8*)(K_lds + (b) * SHM_K + kst0) = sl[i].k0; \
        if (MODE == 0) *(LAS bf16x8*)(K_lds + (b) * SHM_K + kst1) = sl[i].k1; } while (0)
#define SWAIT() asm volatile("s_waitcnt vmcnt(0)" ::: "memory")
#define RESC(al) do { if (__any((al) < 1.f)) { if (hi == 0) al_l[r32] = (al); asm volatile("s_waitcnt lgkmcnt(0)" ::: "memory"); \
        _Pragma("unroll") for (int d = 0; d < 2; ++d) _Pragma("unroll") for (int r = 0; r < 16; ++r) o[d][r] *= al_l[crow(r, hi)]; } } while (0)
    f32x16 pA0, pA1, pB0, pB1; float alA = 1.f, alB = 1.f; bf16x8 pa0, pa1, pa2, pa3;
    const int N = a.t1 - a.t0, T0 = a.t0, n = wid * 32 + r32;
#define NEED(t) (MODE == 0 ? true : (32 * wid + 159 - 64 * (t) >= 0 && 32 * wid + 65 - 64 * (t) <= 128))
    if constexpr (MODE == 0) {
        float qs = 0.f;
#pragma unroll
        for (int d0 = 0; d0 < NQ; ++d0) { f32x4 v0, v1; unpack8(__builtin_bit_cast(u32x4, qr[d0]), v0, v1); qs += (v0[0] * v0[0] + v0[1] * v0[1]) + (v0[2] * v0[2] + v0[3] * v0[3]) + (v1[0] * v1[0] + v1[1] * v1[1]) + (v1[2] * v1[2] + v1[3] * v1[3]); }
        qs = sum32(qs);
        const float nb_ = -sqrtf(qs) * a.kn;
        f32x16 negm;
#pragma unroll
        for (int r = 0; r < 16; ++r) negm[r] = nb_;
#define SGB_QK() do { _Pragma("unroll") for (int _g = 0; _g < 12; ++_g) { __builtin_amdgcn_sched_group_barrier(0x008, 1, 0); __builtin_amdgcn_sched_group_barrier(0x100, 2, 0); \
        __builtin_amdgcn_sched_group_barrier(0x002, 6, 0); } } while (0)
#define SGB_PV() do { _Pragma("unroll") for (int _g = 0; _g < 8; ++_g) { __builtin_amdgcn_sched_group_barrier(0x008, 1, 0); __builtin_amdgcn_sched_group_barrier(0x400, 4, 0); } } while (0)
#define PVEXP(vb_, P0, P1) do { \
        { const s16x4 l0 = tr_read<v_rd_off(0, 0, 0)>(vb_), h0 = tr_read<v_rd_off(0, 0, 1)>(vb_), l1 = tr_read<v_rd_off(0, 1, 0)>(vb_), h1 = tr_read<v_rd_off(0, 1, 1)>(vb_); \
          const s16x4 l2 = tr_read<v_rd_off(0, 2, 0)>(vb_), h2 = tr_read<v_rd_off(0, 2, 1)>(vb_), l3 = tr_read<v_rd_off(0, 3, 0)>(vb_), h3 = tr_read<v_rd_off(0, 3, 1)>(vb_); \
          asm volatile("s_waitcnt lgkmcnt(0)" ::: "memory"); SBAR(); \
          o[0] = __builtin_amdgcn_mfma_f32_32x32x16_bf16(pa0, PKV(l0, h0), o[0], 0, 0, 0); o[0] = __builtin_amdgcn_mfma_f32_32x32x16_bf16(pa1, PKV(l1, h1), o[0], 0, 0, 0); \
          o[0] = __builtin_amdgcn_mfma_f32_32x32x16_bf16(pa2, PKV(l2, h2), o[0], 0, 0, 0); o[0] = __builtin_amdgcn_mfma_f32_32x32x16_bf16(pa3, PKV(l3, h3), o[0], 0, 0, 0); \
          _Pragma("unroll") for (int r = 0; r < 16; ++r) P0[r] = __builtin_amdgcn_exp2f(P0[r]); \
          _Pragma("unroll") for (int _g = 0; _g < 4; ++_g) { __builtin_amdgcn_sched_group_barrier(0x008, 1, 0); __builtin_amdgcn_sched_group_barrier(0x400, 4, 0); } SBAR(); } \
        { const s16x4 l0 = tr_read<v_rd_off(1, 0, 0)>(vb_), h0 = tr_read<v_rd_off(1, 0, 1)>(vb_), l1 = tr_read<v_rd_off(1, 1, 0)>(vb_), h1 = tr_read<v_rd_off(1, 1, 1)>(vb_); \
          const s16x4 l2 = tr_read<v_rd_off(1, 2, 0)>(vb_), h2 = tr_read<v_rd_off(1, 2, 1)>(vb_), l3 = tr_read<v_rd_off(1, 3, 0)>(vb_), h3 = tr_read<v_rd_off(1, 3, 1)>(vb_); \
          asm volatile("s_waitcnt lgkmcnt(0)" ::: "memory"); SBAR(); \
          o[1] = __builtin_amdgcn_mfma_f32_32x32x16_bf16(pa0, PKV(l0, h0), o[1], 0, 0, 0); o[1] = __builtin_amdgcn_mfma_f32_32x32x16_bf16(pa1, PKV(l1, h1), o[1], 0, 0, 0); \
          o[1] = __builtin_amdgcn_mfma_f32_32x32x16_bf16(pa2, PKV(l2, h2), o[1], 0, 0, 0); o[1] = __builtin_amdgcn_mfma_f32_32x32x16_bf16(pa3, PKV(l3, h3), o[1], 0, 0, 0); \
          _Pragma("unroll") for (int r = 0; r < 16; ++r) P1[r] = __builtin_amdgcn_exp2f(P1[r]); \
          _Pragma("unroll") for (int _g = 0; _g < 4; ++_g) { __builtin_amdgcn_sched_group_barrier(0x008, 1, 0); __builtin_amdgcn_sched_group_barrier(0x400, 4, 0); } SBAR(); } } while (0)
#define PKV(L, H) (bf16x8){L[0], L[1], L[2], L[3], H[0], H[1], H[2], H[3]}
#define EXP32(P0, P1) do { _Pragma("unroll") for (int r = 0; r < 16; ++r) { P0[r] = __builtin_amdgcn_exp2f(P0[r]); P1[r] = __builtin_amdgcn_exp2f(P1[r]); } } while (0)
#define PACKSUM(P0, P1) do { float s_ = 0.f; _Pragma("unroll") for (int r = 0; r < 16; ++r) s_ += P0[r] + P1[r]; l_reg += s_; \
        PK4_(P0, 0, pa0); PK4_(P0, 8, pa1); PK4_(P1, 0, pa2); PK4_(P1, 8, pa3); } while (0)
#define PK4_(P, BASE, OUT) do { u32x4 w = {cvtpk(P[BASE + 0], P[BASE + 1]), cvtpk(P[BASE + 2], P[BASE + 3]), cvtpk(P[BASE + 4], P[BASE + 5]), cvtpk(P[BASE + 6], P[BASE + 7])}; \
        OUT = __builtin_bit_cast(bf16x8, w); } while (0)
        LAS char* const V0 = lds + 3 * SHM_K;
        const int vbase = (int)(uintptr_t)V0 + v_rd_base(lane);
        unsigned koff[2]; bool krope[2];
#pragma unroll
        for (int i = 0; i < 2; ++i) { const int row = 8 * wid + 4 * i + (lane >> 4), c = (lane & 15) ^ (row & 7); krope[i] = c >= 8;
            koff[i] = krope[i] ? (unsigned)(row * a.ldk2 + ((c - 8) & 3) * 8) * 2u : (unsigned)(row * a.ldk + c * 8) * 2u; }
        const int kk_ = 8 * wid + ((lane & 31) >> 2); const int vkey = kk_;
        const unsigned voff = (unsigned)(vkey * a.ldv + 32 * (lane >> 5) + 8 * (lane & 3)) * 2u;
        const unsigned ldsK = (unsigned)(uintptr_t)lds + (unsigned)wid * 2048u, ldsV = (unsigned)(uintptr_t)V0 + (unsigned)wid * 1024u;
#define DMA_TILE(t_, slot_) do { const char* kb_ = (const char*)a.K + (size_t)(t_) * 128 * a.ldk; const char* k2_ = (const char*)a.K2 + (size_t)(t_) * 128 * a.ldk2; const char* vb_ = (const char*)a.V + (size_t)(t_) * 128 * a.ldv; \
        _Pragma("unroll") for (int i_ = 0; i_ < 2; ++i_) { const char* src_ = (krope[i_] ? k2_ : kb_) + koff[i_]; const unsigned la_ = ldsK + (unsigned)(slot_) * SHM_K + i_ * 1024u; \
            asm volatile("s_mov_b32 m0, %1\n\ts_nop 0\n\tglobal_load_lds_dwordx4 %0, off" :: "v"(src_), "s"(la_) : "memory", "m0"); } \
        { const unsigned la_ = ldsV + (unsigned)(slot_) * SHM_V; asm volatile("s_mov_b32 m0, %2\n\ts_nop 0\n\tglobal_load_lds_dwordx4 %0, %1" :: "v"(voff), "s"(vb_), "s"(la_) : "memory", "m0"); } } while (0)
#define STEP_END() do { asm volatile("s_waitcnt vmcnt(0)" ::: "memory"); __syncthreads(); } while (0)
        DMA_TILE(T0, 0); STEP_END();
        DMA_TILE(T0 + 1, 1);
        qkt_c<NQ>(pA0, pA1, K_lds, qr, r32, hi, negm); if (T0 >= a.tmask) mask_tile<MODE>(pA0, pA1, T0, n, hi, a); EXP32(pA0, pA1);
        STEP_END();
        int sc_ = 1, sp_ = 0, sn_ = 2;
#define STEP0(t_, PX0, PX1, PY0, PY1, MK) do { \
        if ((t_) + 1 < N) DMA_TILE(T0 + (t_) + 1, sn_); \
        SBAR(); qkt_c<NQ>(PX0, PX1, K_lds + sc_ * SHM_K, qr, r32, hi, negm); if (MK) mask_tile<MODE>(PX0, PX1, T0 + (t_), n, hi, a); \
        PACKSUM(PY0, PY1); SGB_QK(); SBAR(); \
        PVEXP(vbase + sp_ * SHM_V, PX0, PX1); \
        STEP_END(); { const int o_ = sp_; sp_ = sc_; sc_ = sn_; sn_ = o_; } } while (0)
        int t = 1;
        for (; t + 5 < N; t += 2) { STEP0(t, pB0, pB1, pA0, pA1, false); STEP0(t + 1, pA0, pA1, pB0, pB1, false); }
        for (; t + 1 < N; t += 2) { STEP0(t, pB0, pB1, pA0, pA1, true); STEP0(t + 1, pA0, pA1, pB0, pB1, true); }
        STEP0(N - 1, pB0, pB1, pA0, pA1, true);
#undef STEP0
#undef DMA_TILE
#undef STEP_END
        PACKSUM(pB0, pB1); SBAR();
        pv_d0(o, vbase + sp_ * SHM_V, pa0, pa1, pa2, pa3);
        l_reg = sum32(l_reg);
#undef SGB_QK
#undef SGB_PV
#undef EXP32
#undef PVEXP
#undef PKV
#undef PACKSUM
#undef PK4_
    } else {
    float qs = 0.f;
#pragma unroll
    for (int d0 = 0; d0 < NQ; ++d0) { f32x4 v0, v1; unpack8(__builtin_bit_cast(u32x4, qr[d0]), v0, v1); qs += (v0[0] * v0[0] + v0[1] * v0[1]) + (v0[2] * v0[2] + v0[3] * v0[3]) + (v1[0] * v1[0] + v1[1] * v1[1]) + (v1[2] * v1[2] + v1[3] * v1[3]); }
    qs = sum32(qs);
    const float nb_ = -sqrtf(qs) * a.kn; m_reg = -nb_;
    f32x16 negm;
#pragma unroll
    for (int r = 0; r < 16; ++r) negm[r] = nb_;
#define EXP32(P0, P1) do { _Pragma("unroll") for (int r = 0; r < 16; ++r) { P0[r] = __builtin_amdgcn_exp2f(P0[r]); P1[r] = __builtin_amdgcn_exp2f(P1[r]); } } while (0)
#define PK4_(P, BASE, OUT) do { u32x4 w = {cvtpk(P[BASE + 0], P[BASE + 1]), cvtpk(P[BASE + 2], P[BASE + 3]), cvtpk(P[BASE + 4], P[BASE + 5]), cvtpk(P[BASE + 6], P[BASE + 7])}; \
        OUT = __builtin_bit_cast(bf16x8, w); } while (0)
#define PACKSUM(P0, P1) do { float s_ = 0.f; _Pragma("unroll") for (int r = 0; r < 16; ++r) s_ += P0[r] + P1[r]; l_reg += s_; \
        PK4_(P0, 0, pa0); PK4_(P0, 8, pa1); PK4_(P1, 0, pa2); PK4_(P1, 8, pa3); } while (0)
    LAS char* const KD = lds; LAS char* const VD = lds + 6 * 8192;
    const int vbase = (int)(uintptr_t)VD + v_rd_base(lane);
    { const int row = 8 * wid + (lane >> 3), c = (lane & 7) ^ (row & 7);
      const unsigned koff = (unsigned)(row * a.ldk + c * 8) * 2u;
      const int kk_ = 8 * wid + ((lane & 31) >> 2); const unsigned voff = (unsigned)(kk_ * a.ldv + 32 * (lane >> 5) + 8 * (lane & 3)) * 2u;
      const unsigned ldsK = (unsigned)(uintptr_t)KD + (unsigned)wid * 1024u, ldsV = (unsigned)(uintptr_t)VD + (unsigned)wid * 1024u;
      for (int t = T0; t < a.t1; ++t) {
          const char* kb_ = (const char*)a.K + (size_t)t * 128 * a.ldk; const char* vb_ = (const char*)a.V + (size_t)t * 128 * a.ldv;
          { const unsigned la_ = ldsK + (unsigned)t * 8192u; asm volatile("s_mov_b32 m0, %2\n\ts_nop 0\n\tglobal_load_lds_dwordx4 %0, %1" :: "v"(koff), "s"(kb_), "s"(la_) : "memory", "m0"); }
          { const unsigned la_ = ldsV + (unsigned)t * 8192u; asm volatile("s_mov_b32 m0, %2\n\ts_nop 0\n\tglobal_load_lds_dwordx4 %0, %1" :: "v"(voff), "s"(vb_), "s"(la_) : "memory", "m0"); } } }
    asm volatile("s_waitcnt vmcnt(0)" ::: "memory"); __syncthreads();
#pragma unroll
    for (int t = 0; t < 6; ++t) {
        if (t >= T0 && NEED(t)) { SBAR(); qkt_c128<NQ>(pA0, pA1, KD + t * 8192, qr, r32, hi, negm); mask_tile<MODE>(pA0, pA1, t, n, hi, a); EXP32(pA0, pA1); PACKSUM(pA0, pA1); SBAR();
            pv_d0(o, vbase + t * 8192, pa0, pa1, pa2, pa3); } }
    l_reg = sum32(l_reg);
#undef EXP32
#undef PACKSUM
#undef PK4_
    }
    if (hi == 0) li_l[r32] = l_reg; asm volatile("s_waitcnt lgkmcnt(0)" ::: "memory");
    float rli[16];
#pragma unroll
    for (int r = 0; r < 16; ++r) rli[r] = __builtin_amdgcn_rcpf(li_l[crow(r, hi)]);
    if constexpr (MODE == 0) {
        unsigned char* Ow = (unsigned char*)a.O + (long)(wid * 32) * a.ldo;
        LAS unsigned char* ost = (LAS unsigned char*)(lds + 3 * SHM_K + 3 * SHM_V + 2048) + wid * (32 * 80);
#pragma unroll
        for (int r = 0; r < 16; ++r) { const int orow = crow(r, hi);
#pragma unroll
            for (int d0 = 0; d0 < 2; ++d0) { const float v_ = fminf(fmaxf(8.0f * o[d0][r] * rli[r], -448.f), 448.f); ost[orow * 80 + d0 * 32 + r32] = (unsigned char)(__builtin_amdgcn_cvt_pk_fp8_f32(v_, 0.f, 0, false) & 0xff); } }
        asm volatile("s_waitcnt lgkmcnt(0)" ::: "memory");
#pragma unroll
        for (int it = 0; it < 2; ++it) { const int orow = it * 16 + (lane >> 2), ch = (lane & 3) * 16;
            *(u32x4*)(Ow + (long)orow * a.ldo + ch) = *(const LAS u32x4*)(ost + orow * 80 + ch); }
    } else {
        bf16_t* Ow = a.O + (long)(wid * 32) * a.ldo;
        __syncthreads();
        LAS bf16_t* ost = (LAS bf16_t*)lds + wid * (32 * 72);
#pragma unroll
        for (int r = 0; r < 16; ++r) { const int orow = crow(r, hi);
#pragma unroll
            for (int d0 = 0; d0 < 2; ++d0) ost[orow * 72 + d0 * 32 + r32] = (bf16_t)(cvtpk(o[d0][r] * rli[r], 0.f) & 0xffffu); }
        asm volatile("s_waitcnt lgkmcnt(0)" ::: "memory");
#pragma unroll
        for (int it = 0; it < 4; ++it) { const int orow = it * 8 + (lane >> 3), ch = (lane & 7) * 8;
            *(u32x4*)(Ow + (long)orow * a.ldo + ch) = *(const LAS u32x4*)(ost + orow * 72 + ch); }
    }
    if (MODE == 1) { if (hi == 0) a.lse[(long)n * a.ldlse] = (m_reg + __builtin_amdgcn_logf(l_reg)) * 0.6931471805599453f; }
    __syncthreads();
#undef NEED
#undef SLOAD
#undef SWRITE
#undef SWAIT
#undef RESC
}
#undef KSWZ
#undef SBAR
}

struct KArgs { const float* in[24]; float* out; unsigned char* ws; };
enum { I_X = 0, I_P, I_ATTN_NORM, I_W_IN, I_Q_NORM, I_W_UQ, I_KV_NORM, I_W_UKV, I_W_A, I_W_B, I_W_OUT, I_FFN_NORM, I_W_ROUTER, I_B_ROUTER,
       I_W_GATE, I_B_GATE, I_W_UP, I_B_UP, I_W_DOWN, I_B_DOWN, I_PLE_NORM, I_W_PG, I_W_PP, I_FINAL_NORM };

__device__ __forceinline__ s16x4 tr_rd(int addr) { s16x4 r; asm volatile("ds_read_b64_tr_b16 %0, %1" : "=&v"(r) : "v"(addr) : "memory"); return r; }
__device__ __forceinline__ s16x4 tr_rd1088(int addr) { s16x4 r; asm volatile("ds_read_b64_tr_b16 %0, %1 offset:1088" : "=&v"(r) : "v"(addr) : "memory"); return r; }
__device__ __forceinline__ s16x4 tr_rd1632(int addr) { s16x4 r; asm volatile("ds_read_b64_tr_b16 %0, %1 offset:1632" : "=&v"(r) : "v"(addr) : "memory"); return r; }
__device__ __forceinline__ s16x4 tr_rd544(int addr) { s16x4 r; asm volatile("ds_read_b64_tr_b16 %0, %1 offset:544" : "=&v"(r) : "v"(addr) : "memory"); return r; }
template <bool F8> __device__ __forceinline__ void tr_item(const float* W, int Nsrc, int sc  , const float* gain, void* WTv, int K, int k0, int n0, LAS char* scr, int lane) {
    constexpr int P = 136;
    const int ks = lane >> 4, n4 = (lane & 15) * 4;
    f32x4 v[16];
#pragma unroll
    for (int i = 0; i < 16; ++i) v[i] = sc >= 0 ? *(const f32x4*)(W + (size_t)(k0 + 4 * i + ks) * Nsrc + sc) : (f32x4){0.f, 0.f, 0.f, 0.f};
    if (gain) {
#pragma unroll
        for (int i = 0; i < 16; ++i) v[i] = v[i] * gain[k0 + 4 * i + ks]; }
#pragma unroll
    for (int i = 0; i < 16; ++i) { u32x2 w; w.x = cvtpk(v[i][0], v[i][1]); w.y = cvtpk(v[i][2], v[i][3]); *(LAS u32x2*)(scr + (4 * i + ks) * P + n4 * 2) = w; }
    LDS_WAIT(); asm volatile("" ::: "memory");
    const int g = lane >> 4, i16 = lane & 15, q = i16 >> 2, p = i16 & 3;
    const int rbase = (int)(uintptr_t)scr + q * P + p * 8;
    s16x4 lo[8], hi[8];
#pragma unroll
    for (int t = 0; t < 8; ++t) { const int nblk = t >> 1, c = (t & 1) * 4 + g; const int addr = rbase + 8 * c * P + nblk * 32; lo[t] = tr_rd(addr); hi[t] = tr_rd544(addr); }
    asm volatile("s_waitcnt lgkmcnt(0)" ::: "memory"); __builtin_amdgcn_sched_barrier(0);
#pragma unroll
    for (int t = 0; t < 8; ++t) { const int nblk = t >> 1, c = (t & 1) * 4 + g;
        if constexpr (F8) {
#define BF2F(x) __uint_as_float((unsigned)(unsigned short)(x) << 16)
            u32x2 o; o.x = pk4_fp8(64.f * BF2F(lo[t][0]), 64.f * BF2F(lo[t][1]), 64.f * BF2F(lo[t][2]), 64.f * BF2F(lo[t][3])); o.y = pk4_fp8(64.f * BF2F(hi[t][0]), 64.f * BF2F(hi[t][1]), 64.f * BF2F(hi[t][2]), 64.f * BF2F(hi[t][3]));
#undef BF2F
            *(u32x2*)((unsigned char*)WTv + (size_t)(n0 + nblk * 16 + i16) * K + k0 + 8 * c) = o;
        } else {
        const bf16x8 o = (bf16x8){lo[t][0], lo[t][1], lo[t][2], lo[t][3], hi[t][0], hi[t][1], hi[t][2], hi[t][3]};
        *(bf16x8*)((bf16_t*)WTv + (size_t)(n0 + nblk * 16 + i16) * K + k0 + 8 * c) = o; } }
    asm volatile("" ::: "memory");
}
__device__ __forceinline__ int rope_perm(int p) { const int j = p >> 3, i = p & 7; return (i < 4) ? 4 * j + i : 16 + 4 * j + (i - 4); }
__device__ __forceinline__ void convert_small(const KArgs& a, unsigned char* ws, int layer, LAS char* scr, int gw, int NGW, int lane) {
    constexpr int I_IN = 16 * 80, I_UQ = 6 * 12, I_UKV = 4 * 16, I_A = 8 * 16, I_B = 4 * 16, I_O = 16 * 16, I_PG = 16 * 16, I_PP = 4 * 16;
    constexpr int NIT = I_IN + I_UQ + I_UKV + I_A + I_B + I_O + I_PG + I_PP;
    const int l4 = (lane & 15) * 4;
    for (int it = gw; it < NIT; it += NGW) {
        int r = it;
        if (r < I_IN) { const int kb = r / 80, nb = r % 80, n = nb * 64 + l4; int sc;
            if (n < 256) sc = 384 + n; else if (n < 640) sc = n - 256; else if (n < 672) sc = 640 + rope_perm(n - 640); else if (n < 768) sc = -1; else if (n < 3072) sc = 672 + (n - 768); else sc = 2976 + (n - 3072);
            tr_item<true>(a.in[I_W_IN] + (size_t)layer * DM * IN_COLS, IN_COLS, sc, a.in[I_ATTN_NORM] + layer * DM, (unsigned char*)(ws + WS_WIN) + (size_t)layer * ZC * DM, DM, kb * 64, nb * 64, scr, lane); continue; } r -= I_IN;
        if (r < I_UQ) { const int kb = r / 12, nb = r % 12, n = nb * 64 + l4, h = n / DQK, off = n % DQK; const int sc = h * DQK + (off < DNOPE ? off : DNOPE + rope_perm(off - DNOPE));
            tr_item<false>(a.in[I_W_UQ] + (size_t)layer * QLORA * 768, 768, sc, a.in[I_Q_NORM] + layer * QLORA, (bf16_t*)(ws + WS_WUQ) + (size_t)layer * 768 * QLORA, QLORA, kb * 64, nb * 64, scr, lane); continue; } r -= I_UQ;
        if (r < I_UKV) { const int kb = r / 16, nb = r % 16;
            tr_item<false>(a.in[I_W_UKV] + (size_t)layer * KVLORA * 1024, 1024, nb * 64 + l4, a.in[I_KV_NORM] + layer * KVLORA, (bf16_t*)(ws + WS_WUKV) + (size_t)layer * 1024 * KVLORA, KVLORA, kb * 64, nb * 64, scr, lane); continue; } r -= I_UKV;
        if (r < I_A) { const int kb = r / 16, nb = r % 16;
            tr_item<true>(a.in[I_W_A] + (size_t)layer * 512 * DM, DM, nb * 64 + l4, nullptr, (unsigned char*)(ws + WS_WA) + (size_t)layer * DM * 512, 512, kb * 64, nb * 64, scr, lane); continue; } r -= I_A;
        if (r < I_B) { const int kb = r / 16, nb = r % 16;
            tr_item<true>(a.in[I_W_B] + (size_t)layer * 256 * DM, DM, nb * 64 + l4, nullptr, (unsigned char*)(ws + WS_WB) + (size_t)layer * DM * 256, 256, kb * 64, nb * 64, scr, lane); continue; } r -= I_B;
        if (r < I_O) { const int kb = r / 16, nb = r % 16;
            tr_item<true>(a.in[I_W_OUT] + (size_t)layer * DM * DM, DM, nb * 64 + l4, nullptr, (unsigned char*)(ws + WS_WO) + (size_t)layer * DM * DM, DM, kb * 64, nb * 64, scr, lane); continue; } r -= I_O;
        if (r < I_PG) { const int kb = r / 16, nb = r % 16;
            tr_item<true>(a.in[I_W_PG] + (size_t)layer * DM * DM, DM, nb * 64 + l4, a.in[I_PLE_NORM] + layer * DM, (unsigned char*)(ws + WS_WPG) + (size_t)layer * DM * DM, DM, kb * 64, nb * 64, scr, lane); continue; } r -= I_PG;
        { const int kb = r / 16, nb = r % 16;
            tr_item<false>(a.in[I_W_PP] + (size_t)layer * PLE * DM, DM, nb * 64 + l4, nullptr, (bf16_t*)(ws + WS_WPP) + (size_t)layer * DM * PLE, PLE, kb * 64, nb * 64, scr, lane); }
    }
}
struct CvtItem { const float* src; const float* gain; unsigned char* dst; int sc, k0, n0; };
__device__ __forceinline__ CvtItem expert_item(const KArgs& a, unsigned char* ws, int layer, int it, int l4) {
    constexpr int I_GU = 16 * 32, I_D = 16 * 16, PER_E = I_GU + I_D;
    CvtItem c; const int e = it / PER_E; int r = it % PER_E;
    if (r < I_GU) { const int kb = r / 32, nb = r % 32, n = nb * 64 + l4, pn = n >> 8, j = n & 255;
        c.src = (j < 128 ? a.in[I_W_GATE] : a.in[I_W_UP]) + ((size_t)layer * NE + e) * DM * DE; c.sc = pn * 128 + (j & 127); c.gain = a.in[I_FFN_NORM] + layer * DM;
        c.dst = (unsigned char*)(ws + WS_WGU) + ((size_t)layer * NE + e) * 2048 * DM; c.k0 = kb * 64; c.n0 = nb * 64;
    } else { r -= I_GU; const int kb = r / 16, nb = r % 16;
        c.src = a.in[I_W_DOWN] + ((size_t)layer * NE + e) * DE * DM; c.sc = nb * 64 + l4; c.gain = nullptr; c.dst = (unsigned char*)(ws + WS_WD) + ((size_t)layer * NE + e) * DM * DE; c.k0 = kb * 64; c.n0 = nb * 64; }
    return c;
}
__device__ __forceinline__ void cvt_load(const CvtItem& c, f32x4 (&v)[16], int lane) {
    const int ks = lane >> 4;
#pragma unroll
    for (int i = 0; i < 16; ++i) v[i] = *(const f32x4*)(c.src + (size_t)(c.k0 + 4 * i + ks) * 1024 + c.sc);
}
__device__ __forceinline__ void cvt_finish(const CvtItem& c, f32x4 (&v)[16], LAS char* scr, const LAS float* g64, int lane) {
    constexpr int P = 136;
    const int ks = lane >> 4, n4 = (lane & 15) * 4;
#pragma unroll
    for (int i = 0; i < 16; ++i) { u32x2 w; w.x = cvtpk(v[i][0], v[i][1]); w.y = cvtpk(v[i][2], v[i][3]); *(LAS u32x2*)(scr + (4 * i + ks) * P + n4 * 2) = w; }
    LDS_WAIT(); asm volatile("" ::: "memory");
    const int g = lane >> 4, i16 = lane & 15, q = i16 >> 2, p = i16 & 3;
    const int rbase = (int)(uintptr_t)scr + q * P + p * 8 + 16 * g * P;
    s16x4 r0[4], r1[4], r2[4], r3[4];
#pragma unroll
    for (int t = 0; t < 4; ++t) { const int addr = rbase + t * 32; r0[t] = tr_rd(addr); r1[t] = tr_rd544(addr); r2[t] = tr_rd1088(addr); r3[t] = tr_rd1632(addr); }
    f32x4 q0 = {64.f, 64.f, 64.f, 64.f}, q1 = q0, q2 = q0, q3 = q0;
    if (c.gain) { const LAS f32x4* gp_ = (const LAS f32x4*)(g64 + c.k0 + 16 * g); q0 = gp_[0]; q1 = gp_[1]; q2 = gp_[2]; q3 = gp_[3]; }
    asm volatile("s_waitcnt lgkmcnt(0)" ::: "memory"); __builtin_amdgcn_sched_barrier(0);
#define BF2F(x) __uint_as_float((unsigned)(unsigned short)(x) << 16)
#define PK4S(v, q) pk4_fp8(q[0] * BF2F(v[0]), q[1] * BF2F(v[1]), q[2] * BF2F(v[2]), q[3] * BF2F(v[3]))
#pragma unroll
    for (int t = 0; t < 4; ++t) { u32x4 o; o.x = PK4S(r0[t], q0); o.y = PK4S(r1[t], q1); o.z = PK4S(r2[t], q2); o.w = PK4S(r3[t], q3);
        *(u32x4*)(c.dst + (size_t)(c.n0 + t * 16 + i16) * 1024 + c.k0 + 16 * g) = o; }
#undef PK4S
#undef BF2F
    asm volatile("" ::: "memory");
}
__device__ __forceinline__ void convert_experts(const KArgs& a, unsigned char* ws, int layer, LAS char* scr, LAS float* g64, int tid, int gw, int NGW, int lane) {
    constexpr int NIT = NE * (16 * 32 + 16 * 16);
    const int l4 = (lane & 15) * 4;
    __syncthreads();
    for (int i = tid; i < DM; i += NTHR) g64[i] = 64.0f * a.in[I_FFN_NORM][layer * DM + i];
    __syncthreads();
    int it = gw; if (it >= NIT) return;
    f32x4 vA[16], vB[16];
    CvtItem c0 = expert_item(a, ws, layer, it, l4), c1 = c0; cvt_load(c0, vA, lane);
    for (;;) {
        const int it1 = it + NGW; const bool h1 = it1 < NIT;
        if (h1) { c1 = expert_item(a, ws, layer, it1, l4); cvt_load(c1, vB, lane); }
        cvt_finish(c0, vA, scr, g64, lane);
        if (!h1) break;
        const int it2 = it1 + NGW; const bool h2 = it2 < NIT;
        if (h2) { c0 = expert_item(a, ws, layer, it2, l4); cvt_load(c0, vA, lane); }
        cvt_finish(c1, vB, scr, g64, lane);
        if (!h2) break;
        it = it2;
    }
}

#define LAYER_VARS \
    const float* xin = layer == 0 ? args.in[I_X] : out; (void)xin; \
    float* rsp_attn = rssb + (size_t)RSP_ATTN * T; float* rsp_ffn = rssb + (size_t)RSP_FFN * T; float* rs_ffn = rssb + (size_t)RS_FFNF * T; float* rs_ple = rssb + (size_t)RS_PLE * T; \
    float* rsp_q = rssb + (size_t)RSP_Q * T; float* rsp_kv = rssb + (size_t)RSP_KV * T; float* rs_attn = rssb + (size_t)RS_ATTNF * T; (void)rs_attn; \
    (void)rsp_attn; (void)rsp_ffn; (void)rs_ffn; (void)rs_ple; (void)rsp_q; (void)rsp_kv;
#define GRID_BAR() do { XcdBarrier b2_ = bar; unsigned long long bb_ = (unsigned long long)bar.bar; asm volatile("" : "+s"(bb_), "+s"(b2_.x)); b2_.bar = (unsigned*)(GAS unsigned*)bb_; xcd_barrier(b2_); } while (0)
#define PHASE_VARS \
    unsigned long long ws_ = (unsigned long long)ws0; asm volatile("" : "+s"(ws_)); unsigned char* ws = (unsigned char*)(GAS unsigned char*)ws_; unsigned long long out_ = (unsigned long long)out0; asm volatile("" : "+s"(out_)); float* out = (float*)(GAS float*)out_; \
    int wave = wave0; asm volatile("" : "+s"(wave)); int lane = (int)__builtin_amdgcn_mbcnt_hi(~0u, __builtin_amdgcn_mbcnt_lo(~0u, 0u)); asm volatile("" : "+v"(lane)); const int tid = wave * 64 + lane; \
    int G = G0, bx = bx0; asm volatile("" : "+s"(G), "+s"(bx)); const int vcu = (G % 8 == 0) ? (bx % 8) * (G / 8) + bx / 8 : bx; const int NGW = G * NWAVES, NGT = G * NTHR; (void)NGW; (void)NGT; (void)vcu; \
    const int gw = vcu * NWAVES + wave; const int gtid = vcu * NTHR + tid; (void)gw; (void)gtid; (void)lane; \
    unsigned* ctl = (unsigned*)(ws + WS_CTL); (void)ctl; \
    float* rssb = (float*)(ws + WS_RSS); float* cosT = (float*)(ws + WS_ROPE); float* sinT = cosT + 8192 * 16; (void)rssb; (void)sinT; \
    bf16_t* xbA = (bf16_t*)(ws + WS_XBA); bf16_t* xbB = (bf16_t*)(ws + WS_XBB); bf16_t* pb = (bf16_t*)(ws + WS_PB); bf16_t* ppb = (bf16_t*)(ws + WS_PP); \
    bf16_t* zm = (bf16_t*)(ws + WS_ZM); bf16_t* zd = (bf16_t*)(ws + WS_ZD); bf16_t* gt = (bf16_t*)(ws + WS_GT); \
    bf16_t* qb = (bf16_t*)(ws + WS_Q); bf16_t* kvb = (bf16_t*)(ws + WS_KV); bf16_t* krb = (bf16_t*)(ws + WS_KR); \
    bf16_t* oab = (bf16_t*)(ws + WS_OA); bf16_t* ogb = (bf16_t*)(ws + WS_OG); float* lseb = (float*)(ws + WS_LSE); bf16_t* obb = (bf16_t*)(ws + WS_OB); \
    bf16_t* mixb = (bf16_t*)(ws + WS_MIX); unsigned char* xq = (unsigned char*)(ws + WS_XQ); unsigned char* hm = (unsigned char*)(ws + WS_HM); bf16_t* yb = (bf16_t*)(ws + WS_Y); (void)yb; \
    int* asg = (int*)(ws + WS_ASG); float* tw = (float*)(ws + WS_TW); int* dstrow = (int*)(ws + WS_DST); int* tokl = (int*)(ws + WS_TOKL); float* wl = (float*)(ws + WS_WL); \
    (void)xbA; (void)xbB; (void)pb; (void)ppb; (void)zm; (void)zd; (void)gt; (void)qb; (void)kvb; (void)krb; (void)oab; (void)ogb; (void)lseb; (void)obb; (void)mixb; (void)xq; (void)hm; (void)asg; (void)tw; (void)dstrow; (void)tokl; (void)wl; \
    bf16_t* xb0 = xbA; bf16_t* xb1 = xbB; (void)xb0; (void)xb1; bf16_t* x3b = (bf16_t*)(ws + WS_X3B); (void)x3b;


#define STAMP() do { if (DIAG) { if (threadIdx.x == 0 && blockIdx.x == 0) ((LAS unsigned long long*)(LC + 1024))[nst] = __builtin_amdgcn_s_memrealtime(); ++nst; } } while (0)
template <int LAYER>
__device__ __forceinline__ void layer_body(const KArgs& args, LAS unsigned char* lds, LAS unsigned* LC, unsigned char* const ws0, float* const out0, const int G0, const int bx0, const int wave0, const XcdBarrier& bar, int& nst) {
    constexpr int layer = LAYER;
        if (layer > 0) { { PHASE_VARS LAYER_VARS
            for (int m = gtid; m < T; m += NGT) rs_attn[m] = sum16(rsp_attn + (size_t)m * 16); }
            GRID_BAR(); }
        for (int rep_ = 0; rep_ < NREP(1); ++rep_) if (PH(1)) { if (rep_) GRID_BAR(); PHASE_VARS LAYER_VARS
            pg8::Gemm g{DM, DM, DM, 0x79797979, 0x7d7d7d7d, (unsigned*)(ws + WS_CTL + 524288)}; pg8::DenseSched S; S.init(xb0, DM, (unsigned char*)(ws + WS_WIN) + (size_t)layer * ZC * DM, DM, T, ZC, G, bx);
            pg8::EpiZ E{rs_attn, rsp_q, rsp_kv, zm, zd, gt, krb, cosT, sinT, ctl + CW_KMAX + layer * 192 + 64};
            pg8::gemm_phase<pg8::EpiZ, pg8::DenseSched, true, true>(lds, g, S, E, wave);
        }
        GRID_BAR(); STAMP();

        for (int rep_ = 0; rep_ < NREP(2); ++rep_) if (PH(2)) { if (rep_) GRID_BAR(); PHASE_VARS LAYER_VARS
            { pg8::Gemm g{ZM_LD * 2, QLORA * 2, QLORA * 2, 0, 0, (unsigned*)(ws + WS_CTL + 524288)}; pg8::DenseSched S; S.init(zm + 256, ZM_LD * 2, (bf16_t*)(ws + WS_WUQ) + (size_t)layer * 768 * QLORA, QLORA * 2, T, 768, G, bx);
              pg8::EpiGen<false> E{qb, Q_LD, rsp_q, 2, 1.0f / QLORA, C2_MLA, nullptr, 0, nullptr, 0, nullptr};
              pg8::gemm_phase<pg8::EpiGen<false>, pg8::DenseSched, true>(lds, g, S, E, wave); }
            { pg8::Gemm g{ZM_LD * 2, KVLORA * 2, KVLORA * 2, 0, 0, (unsigned*)(ws + WS_CTL + 524288)}; pg8::DenseSched S; S.init(zm, ZM_LD * 2, (bf16_t*)(ws + WS_WUKV) + (size_t)layer * 1024 * KVLORA, KVLORA * 2, T, 1024, G, bx);
              pg8::EpiGen<true> E{kvb, KV_LD, rsp_kv, 1, 1.0f / KVLORA, 1.0f, nullptr, 0, nullptr, 0, ctl + CW_KMAX + layer * 192};
              pg8::gemm_phase<pg8::EpiGen<true>, pg8::DenseSched, true>(lds, g, S, E, wave); }
            const int per_cu = (1536 + G - 1) / G;
            for (int ui = vcu * per_cu; ui < 1536 && ui < (vcu + 1) * per_cu; ++ui) {
                const int uin = ui & 31, h = (ui >> 5) & 3, gq = (ui >> 7) % 3, b = ui / 384;
                const int dil = gq == 0 ? 1 : (gq == 1 ? 4 : 16); const int nblk = SEQ / (256 * dil); const int r = uin / nblk, u = uin % nblk;
                const long tok0 = (long)b * SEQ + (long)256 * u * dil + r;
                att::Args A;
                A.Q = zd + tok0 * ZD_LD + gq * 768 + h * 64; A.ldq = (long)dil * ZD_LD;
                A.K = zd + (tok0 - (long)128 * dil) * ZD_LD + gq * 768 + 256 + h * 64; A.ldk = (long)dil * ZD_LD; A.K2 = nullptr; A.ldk2 = 0;
                A.V = zd + (tok0 - (long)128 * dil) * ZD_LD + gq * 768 + 512 + h * 64; A.ldv = (long)dil * ZD_LD;
                A.O = ogb + (size_t)gq * T * 256 + tok0 * 256 + h * 64; A.ldo = (long)dil * 256;
                A.lse = lseb + (size_t)gq * T * 4 + tok0 * 4 + h; A.ldlse = (long)dil * 4;
                A.t0 = (u == 0) ? 2 : 0; A.t1 = 6; A.qoff = 128; A.tmask = 0; A.cosT = nullptr; A.sinT = nullptr;
                { const unsigned* kd_ = ctl + CW_KMAX + layer * 192 + 80 + ((b * 3 + gq) * 4 + h) * 2; A.kn = 1.02f * sqrtf(__uint_as_float(kd_[0]) + __uint_as_float(kd_[1])); }
                { const int si = gq * 4 + h;
                  const float ex = si < 8 ? 0.5f * (float)(si + 1) : (float)(si - 3);
                  A.ab = exp2f(-ex) * (float)dil * LOG2E; }
                att::attn_unit<1>(A, (LAS char*)lds, wave);
            }
        }
        GRID_BAR(); STAMP();

        for (int rep_ = 0; rep_ < NREP(3); ++rep_) if (PH(3)) { if (rep_) GRID_BAR(); PHASE_VARS LAYER_VARS
            const int cvt_at = (G == 256) ? ((vcu >> 3) & 3) : -1;
            const int nun = (G == 256) ? 4 : (1024 + G - 1) / G;
            const int isplit = cvt_at < 0 ? nun : cvt_at;
#define P3_UNITS(I0, I1) \
            for (int i = (I0); i < (I1); ++i) { \
                int bh, qblk; \
                if (G == 256) { const int s = vcu & 7; bh = vcu >> 3; qblk = (i == 0) ? 31 - s : (i == 1) ? 16 + s : (i == 2) ? 15 - s : s; } \
                else { const int ui = i * G + vcu; if (ui >= 1024) break; bh = ui >> 5; qblk = ui & 31; } \
                const int b = bh >> 3, h = bh & 7; const long row0 = (long)b * SEQ; \
                att::Args A; \
                A.Q = qb + (row0 + 256 * qblk) * Q_LD + h * DQK; A.ldq = Q_LD; \
                A.K = kvb + row0 * KV_LD + h * 128; A.ldk = KV_LD; A.K2 = krb + row0 * 32; A.ldk2 = 32; \
                A.V = kvb + row0 * KV_LD + h * 128 + 64; A.ldv = KV_LD; \
                A.O = (bf16_t*)((unsigned char*)oab + (row0 + 256 * qblk) * 512 + h * 64); A.ldo = 512; A.lse = nullptr; A.ldlse = 0; \
                A.t0 = 0; A.t1 = 4 * (qblk + 1); A.qoff = 256 * qblk; A.tmask = 4 * qblk; A.ab = 0.f; A.cosT = cosT; A.sinT = sinT; \
                { const unsigned* km_ = ctl + CW_KMAX + layer * 192; \
                  A.kn = 1.02f * sqrtf(__uint_as_float(km_[(b * NH + h) * 2]) + __uint_as_float(km_[(b * NH + h) * 2 + 1]) + __uint_as_float(km_[64 + b])); } \
                att::attn_unit<0>(A, (LAS char*)lds, wave); \
            }
            P3_UNITS(0, isplit)
            if (cvt_at >= 0) { if (layer == 0) { const float* p = args.in[I_P]; const size_t n8 = (size_t)2 * T * PLE / 8;
                  for (size_t i = gtid; i < n8; i += NGT) { const f32x4 a0 = *(const f32x4*)(p + i * 8), a1 = *(const f32x4*)(p + i * 8 + 4); *(u32x4*)(pb + i * 8) = pack8(a0, a1); }
                  convert_small(args, ws, 1, (LAS char*)(lds + wave * 16384), gw, NGW, lane); }
                convert_experts(args, ws, layer, (LAS char*)(lds + wave * 16384), (LAS float*)(lds + RL_OFF), tid, gw, NGW, lane); __syncthreads(); }
            P3_UNITS(isplit, nun)
#undef P3_UNITS
            for (int m = gw; m < T; m += NGW) {
                const int h = lane >> 4;
                const float l0 = lseb[(size_t)0 * T * 4 + (size_t)m * 4 + h], l1 = lseb[(size_t)1 * T * 4 + (size_t)m * 4 + h], l2 = lseb[(size_t)2 * T * 4 + (size_t)m * 4 + h];
                const float mx = fmaxf(l0, fmaxf(l1, l2)); const float e0 = __expf(l0 - mx), e1 = __expf(l1 - mx), e2 = __expf(l2 - mx); const float inv = 1.0f / (e0 + e1 + e2);
                const u32x2 a0 = *(const u32x2*)(ogb + (size_t)0 * T * 256 + (size_t)m * 256 + lane * 4), a1 = *(const u32x2*)(ogb + (size_t)1 * T * 256 + (size_t)m * 256 + lane * 4), a2 = *(const u32x2*)(ogb + (size_t)2 * T * 256 + (size_t)m * 256 + lane * 4);
                const float w0 = e0 * inv, w1 = e1 * inv, w2 = e2 * inv;
                const float r0 = w0 * bflo(a0.x) + w1 * bflo(a1.x) + w2 * bflo(a2.x), r1 = w0 * bfhi(a0.x) + w1 * bfhi(a1.x) + w2 * bfhi(a2.x);
                const float r2 = w0 * bflo(a0.y) + w1 * bflo(a1.y) + w2 * bflo(a2.y), r3 = w0 * bfhi(a0.y) + w1 * bfhi(a1.y) + w2 * bfhi(a2.y);
                *(unsigned*)((unsigned char*)obb + (size_t)m * 256 + lane * 4) = pk4_fp8(8.f * r0, 8.f * r1, 8.f * r2, 8.f * r3);
            }
        }
        GRID_BAR(); STAMP();

        for (int rep_ = 0; rep_ < NREP(5); ++rep_) if (PH(5)) { if (rep_) GRID_BAR(); PHASE_VARS LAYER_VARS
            { pg8::Gemm g{256, 256, 256, 0x79797979, 0x7c7c7c7c, (unsigned*)(ws + WS_CTL + 524288)}; pg8::DenseSched S; S.init(obb, 256, (unsigned char*)(ws + WS_WB) + (size_t)layer * DM * 256, 256, T, DM, G, bx);
              pg8::EpiGen<false> E{mixb, DM, nullptr, 0, 0.f, 1.0f, gt + 1024, GT_LD, nullptr, 0, nullptr};
              pg8::gemm_phase<pg8::EpiGen<false>, pg8::DenseSched, true, true>(lds, g, S, E, wave); }
            { pg8::Gemm g{512, 512, 512, 0x79797979, 0x7c7c7c7c, (unsigned*)(ws + WS_CTL + 524288)}; pg8::DenseSched S; S.init(oab, 512, (unsigned char*)(ws + WS_WA) + (size_t)layer * DM * 512, 512, T, DM, G, bx);
              pg8::EpiGen<false, true> E{(bf16_t*)xq, DM, nullptr, 0, 0.f, 1.0f, gt, GT_LD, mixb, DM, nullptr};
              pg8::gemm_phase<pg8::EpiGen<false, true>, pg8::DenseSched, true, true>(lds, g, S, E, wave); }
            { pg8::Gemm g{PLE * 2, PLE * 2, PLE * 2, 0, 0, (unsigned*)(ws + WS_CTL + 524288)}; pg8::DenseSched S; S.init(pb + (size_t)layer * T * PLE, PLE * 2, (bf16_t*)(ws + WS_WPP) + (size_t)layer * DM * PLE, PLE * 2, T, DM, G, bx);
              pg8::EpiGen<false> E{ppb, DM, nullptr, 0, 0.f, 1.0f, nullptr, 0, nullptr, 0, nullptr};
              pg8::gemm_phase<pg8::EpiGen<false>, pg8::DenseSched, true>(lds, g, S, E, wave); }
        }
        GRID_BAR(); STAMP();

        for (int rep_ = 0; rep_ < NREP(6); ++rep_) if (PH(6)) { if (rep_) GRID_BAR(); PHASE_VARS LAYER_VARS
            pg8::Gemm g{DM, DM, DM, 0x79797979, 0x7c7c7c7c, (unsigned*)(ws + WS_CTL + 524288)}; pg8::DenseSched S; S.init(xq, DM, (unsigned char*)(ws + WS_WO) + (size_t)layer * DM * DM, DM, T, DM, G, bx);
            pg8::EpiRes<false> E{x3b, xb1, nullptr, rsp_ffn, nullptr, nullptr};
            pg8::gemm_phase<pg8::EpiRes<false>, pg8::DenseSched, true, true>(lds, g, S, E, wave);
        }
        GRID_BAR(); STAMP();

        for (int rep_ = 0; rep_ < NREP(7); ++rep_) if (PH(7)) { if (rep_) GRID_BAR(); PHASE_VARS LAYER_VARS
            const float* wr2 = (const float*)(ws + WS_WR) + (size_t)layer * 32768;
            const float* brt = args.in[I_B_ROUTER] + layer * NE;
            unsigned* cnt = ctl + CW_CNT + layer * NE;
            LAS float* exch = (LAS float*)lds;
            LAS int* hist = (LAS int*)(LC + LT_HIST); LAS int* base = (LAS int*)(LC + LT_BASE);
            const int tile = wave & 3, kh = wave >> 2, r32 = lane & 31, hi = lane >> 5;
            for (int tb = vcu; tb < T / 128; tb += G) {
                { const char* wsrc = (const char*)wr2; const unsigned voff_ = (unsigned)lane * 16u;
#pragma unroll
                  for (int pc = 0; pc < 16; ++pc) { const unsigned la_ = (unsigned)(uintptr_t)lds + (unsigned)(wave * 16 + pc) * 1024u; const char* sb_ = wsrc + (size_t)(wave * 16 + pc) * 1024;
                      asm volatile("s_mov_b32 m0, %2\n\ts_nop 0\n\tglobal_load_lds_dwordx4 %0, %1" :: "v"(voff_), "s"(sb_), "s"(la_) : "memory", "m0"); }
                  asm volatile("s_waitcnt vmcnt(0)" ::: "memory"); __syncthreads(); }
                const int tok = tb * 128 + tile * 32 + r32;
                const bf16_t* xp = xb1 + (size_t)tok * DM + kh * 512 + 4 * hi;
                const LAS float* wp = (const LAS float*)lds + ((size_t)(kh * 64) * 64 + lane) * 4;
                f32x16 acc = {};
#pragma unroll 16
                for (int c = 0; c < 64; ++c) { const u32x2 xw = *(const u32x2*)(xp + 8 * c); const f32x4 xv = {bflo(xw.x), bfhi(xw.x), bflo(xw.y), bfhi(xw.y)}; const f32x4 wv = *(const LAS f32x4*)(wp + c * 256);
                    acc = __builtin_amdgcn_mfma_f32_32x32x2f32(wv.x, xv.x, acc, 0, 0, 0); acc = __builtin_amdgcn_mfma_f32_32x32x2f32(wv.y, xv.y, acc, 0, 0, 0);
                    acc = __builtin_amdgcn_mfma_f32_32x32x2f32(wv.z, xv.z, acc, 0, 0, 0); acc = __builtin_amdgcn_mfma_f32_32x32x2f32(wv.w, xv.w, acc, 0, 0, 0); }
                __syncthreads();
                if (kh == 1) {
#pragma unroll
                    for (int r = 0; r < 16; ++r) exch[(tile * 16 + r) * 64 + lane] = acc[r]; }
                __syncthreads();
                int idx[4] = {0, 0, 0, 0}; float wgt[4] = {0.f, 0.f, 0.f, 0.f}; int lrank[4] = {0, 0, 0, 0};
                if (kh == 0) {
                    const float rsum = sum16(rsp_ffn + (size_t)tok * 16); if (hi == 0) rs_ffn[tok] = rsum;
                    const float rstd = __builtin_amdgcn_rsqf(rsum * (1.0f / DM) + EPS);
                    float v[16];
#pragma unroll
                    for (int r = 0; r < 16; ++r) v[r] = (acc[r] + exch[(tile * 16 + r) * 64 + lane]) * rstd + brt[crow(r, hi)];
                    float tv[4]; int ti[4];
#pragma unroll
                    for (int t = 0; t < 4; ++t) { float best = -INFINITY; int bi = 0;
#pragma unroll
                        for (int r = 0; r < 16; ++r) { if (v[r] > best) { best = v[r]; bi = r; } }
                        tv[t] = best; ti[t] = crow(bi, hi);
#pragma unroll
                        for (int r = 0; r < 16; ++r) v[r] = (r == bi) ? -INFINITY : v[r]; }
                    float cv[8]; int ci[8];
#pragma unroll
                    for (int t = 0; t < 4; ++t) { auto rv = __builtin_amdgcn_permlane32_swap(__float_as_uint(tv[t]), __float_as_uint(tv[t]), false, false); auto ri = __builtin_amdgcn_permlane32_swap((unsigned)ti[t], (unsigned)ti[t], false, false);
                        cv[t] = __uint_as_float(rv[0]); ci[t] = (int)ri[0]; cv[4 + t] = __uint_as_float(rv[1]); ci[4 + t] = (int)ri[1]; }
#pragma unroll
                    for (int t = 0; t < 4; ++t) { float best = -INFINITY; int be = 1 << 30; int bi = 0;
#pragma unroll
                        for (int r = 0; r < 8; ++r) { if (cv[r] > best || (cv[r] == best && ci[r] < be)) { best = cv[r]; be = ci[r]; bi = r; } }
                        wgt[t] = best; idx[t] = be;
#pragma unroll
                        for (int r = 0; r < 8; ++r) cv[r] = (r == bi) ? -INFINITY : cv[r]; }
                    const float e1 = __expf(wgt[1] - wgt[0]), e2 = __expf(wgt[2] - wgt[0]), e3 = __expf(wgt[3] - wgt[0]); const float inv = 1.0f / (1.0f + e1 + e2 + e3);
                    wgt[0] = inv; wgt[1] = e1 * inv; wgt[2] = e2 * inv; wgt[3] = e3 * inv;
                    if (hi == 0) {
#pragma unroll
                        for (int t = 0; t < 4; ++t) lrank[t] = __hip_atomic_fetch_add(hist + idx[t], 1, __ATOMIC_RELAXED, __HIP_MEMORY_SCOPE_WORKGROUP); }
                }
                __syncthreads();
                if (tid < NE) { const int hcount = hist[tid]; base[tid] = (int)__hip_atomic_fetch_add(cnt + tid, (unsigned)hcount, __ATOMIC_RELAXED, __HIP_MEMORY_SCOPE_AGENT); hist[tid] = 0; }
                __syncthreads();
                if (kh == 0 && hi == 0) {
#pragma unroll
                    for (int t = 0; t < 4; ++t) { const int slot = base[idx[t]] + lrank[t]; asg[(size_t)tok * 4 + t] = (idx[t] << 16) | slot;
                        tokl[(size_t)idx[t] * 32768 + slot] = tok; wl[(size_t)idx[t] * 32768 + slot] = wgt[t]; } }
                for (int i0 = 0; i0 < 16; i0 += 4) {
                    float scv[4]; u32x4 a0v[4], a1v[4];
#pragma unroll
                    for (int i = 0; i < 4; ++i) { const int m = tb * 128 + wave * 16 + i0 + i;
                        scv[i] = sum16(rsp_ffn + (size_t)m * 16); a0v[i] = *(const u32x4*)(xb1 + (size_t)m * DM + lane * 8); a1v[i] = *(const u32x4*)(xb1 + (size_t)m * DM + 512 + lane * 8); }
#pragma unroll
                    for (int i = 0; i < 4; ++i) { const int m = tb * 128 + wave * 16 + i0 + i;
                        const float sc = __builtin_amdgcn_rsqf(scv[i] * (1.0f / DM) + EPS) * 8.0f;
                        f32x4 f0, f1, f2, f3; unpack8(a0v[i], f0, f1); unpack8(a1v[i], f2, f3); f0 = f0 * sc; f1 = f1 * sc; f2 = f2 * sc; f3 = f3 * sc;
                        u32x2 w0, w1; w0.x = pk4_fp8(f0[0], f0[1], f0[2], f0[3]); w0.y = pk4_fp8(f1[0], f1[1], f1[2], f1[3]); w1.x = pk4_fp8(f2[0], f2[1], f2[2], f2[3]); w1.y = pk4_fp8(f3[0], f3[1], f3[2], f3[3]);
                        *(u32x2*)(xq + (size_t)m * DM + lane * 8) = w0; *(u32x2*)(xq + (size_t)m * DM + 512 + lane * 8) = w1; }
                }
                __syncthreads();
            }
        }
        GRID_BAR(); STAMP();

        for (int rep_ = 0; rep_ < NREP(9); ++rep_) if (PH(9)) { if (rep_) GRID_BAR(); PHASE_VARS LAYER_VARS
            LAS int* ucum = (LAS int*)(LC + LT_UCUM); LAS int* rb0 = (LAS int*)(LC + LT_RB0); LAS int* cntl = (LAS int*)(LC + LT_HIST);
            LAS unsigned short* rowlist = (LAS unsigned short*)(lds + RL_OFF);
            const unsigned* cnt = ctl + CW_CNT + layer * NE;
            if (tid < NE) cntl[tid] = (int)__hip_atomic_load(cnt + tid, __ATOMIC_RELAXED, __HIP_MEMORY_SCOPE_AGENT);
            __syncthreads();
            if (tid == 0) { int rb = 0, uc = 0; for (int e = 0; e < NE; ++e) { const int nb = (cntl[e] + 255) >> 8; rb0[e] = rb; ucum[e] = uc; rb += nb; uc += nb * 8; } rb0[NE] = rb; ucum[NE] = uc; }
            __syncthreads();
            pg8::Gemm g{DM, DM, DM, 0x79797979, 0x7c7c7c7c, (unsigned*)(ws + WS_CTL + 524288)};
            pg8::MoeSched S{(const char*)xq, (const char*)(ws + WS_WGU) + (size_t)layer * NE * 2048 * DM, (size_t)256 * DM, (size_t)256 * DM, (size_t)2048 * DM, 8, G, bx, ucum, rb0, true};
            {
                pg8::Unit u;
                for (int i = wave; i < 17 && S.next(i, u); i += NWAVES) {
#pragma unroll
                    for (int rr = 0; rr < 4; ++rr) { const int r_ = rr * 64 + lane; const int slot = u.rl * 256 + r_; rowlist[i * 256 + r_] = (unsigned short)(slot < cntl[u.aux] ? tokl[(size_t)u.aux * 32768 + slot] : 0); } }
            }
            __syncthreads();
            pg8::EpiSwiglu E{hm, args.in[I_B_GATE] + (size_t)layer * NE * DE, args.in[I_B_UP] + (size_t)layer * NE * DE};
            pg8::gemm_phase<pg8::EpiSwiglu, pg8::MoeSched, true, true, true>(lds, g, S, E, wave, rowlist);
            for (int e = tid; e < NE; e += NTHR) cntl[e] = 0;
        }
        GRID_BAR(); STAMP();

        for (int rep_ = 0; rep_ < NREP(10); ++rep_) if (PH(10)) { if (rep_) GRID_BAR(); PHASE_VARS LAYER_VARS
            LAS int* ucum = (LAS int*)(LC + LT_UCUM); LAS int* rb0 = (LAS int*)(LC + LT_RB0);
            __syncthreads();
            if (tid == 0) { int uc = 0; for (int e = 0; e < NE; ++e) { ucum[e] = uc; uc += (rb0[e + 1] - rb0[e]) * 4; } ucum[NE] = uc; }
            __syncthreads();
            pg8::Gemm g{DE, DE, DE, 0x79797979, 0x7d7d7d7d, (unsigned*)(ws + WS_CTL + 524288)};
            pg8::MoeSched S{(const char*)hm, (const char*)(ws + WS_WD) + (size_t)layer * NE * DM * DE, (size_t)256 * DE, (size_t)256 * DE, (size_t)DM * DE, 4, G, bx, ucum, rb0, false};
            pg8::EpiDown E{(unsigned char*)yb, wl, args.in[I_B_DOWN] + (size_t)layer * NE * DM};
            pg8::gemm_phase<pg8::EpiDown, pg8::MoeSched, true, true>(lds, g, S, E, wave);
        }
        GRID_BAR(); STAMP();

        for (int rep_ = 0; rep_ < NREP(11); ++rep_) if (PH(11)) { if (rep_) GRID_BAR(); PHASE_VARS LAYER_VARS
            const LAS int* rb0p = (const LAS int*)(LC + LT_RB0);
            const unsigned char* y8 = (const unsigned char*)yb;
            for (int m = gw; m < T; m += NGW) {
                f32x4 v0, v1, v2, v3; unpack8(*(const u32x4*)(xb1 + (size_t)m * DM + lane * 8), v0, v1); unpack8(*(const u32x4*)(xb1 + (size_t)m * DM + 512 + lane * 8), v2, v3);
                f32x4 s0 = {0.f, 0.f, 0.f, 0.f}, s1 = s0, s2 = s0, s3 = s0;
#pragma unroll
                for (int t = 0; t < 4; ++t) { const int as_ = asg[(size_t)m * 4 + t]; const int dst = rb0p[as_ >> 16] * 256 + (as_ & 0xffff);
                    const u32x2 ya = *(const u32x2*)(y8 + (size_t)dst * DM + lane * 8), yc = *(const u32x2*)(y8 + (size_t)dst * DM + 512 + lane * 8);
                    s0 = s0 + unpack4_fp8(ya.x); s1 = s1 + unpack4_fp8(ya.y); s2 = s2 + unpack4_fp8(yc.x); s3 = s3 + unpack4_fp8(yc.y); }
                v0 = v0 + s0 * 0.125f; v1 = v1 + s1 * 0.125f; v2 = v2 + s2 * 0.125f; v3 = v3 + s3 * 0.125f;
                *(u32x4*)(xb1 + (size_t)m * DM + lane * 8) = pack8(v0, v1); *(u32x4*)(xb1 + (size_t)m * DM + 512 + lane * 8) = pack8(v2, v3);
                { u32x2 w0, w1; w0.x = pk4_fp8(4.f * v0[0], 4.f * v0[1], 4.f * v0[2], 4.f * v0[3]); w0.y = pk4_fp8(4.f * v1[0], 4.f * v1[1], 4.f * v1[2], 4.f * v1[3]);
                  w1.x = pk4_fp8(4.f * v2[0], 4.f * v2[1], 4.f * v2[2], 4.f * v2[3]); w1.y = pk4_fp8(4.f * v3[0], 4.f * v3[1], 4.f * v3[2], 4.f * v3[3]);
                  *(u32x2*)(xq + (size_t)m * DM + lane * 8) = w0; *(u32x2*)(xq + (size_t)m * DM + 512 + lane * 8) = w1; }
                float s = 0.f;
#pragma unroll
                for (int i = 0; i < 4; ++i) s += v0[i] * v0[i] + v1[i] * v1[i] + v2[i] * v2[i] + v3[i] * v3[i];
                s = wave_sum(s);
                if (lane == 0) rs_ple[m] = s;
            }
            if (layer == 0 && G != 256) { __syncthreads(); convert_experts(args, ws, 1, (LAS char*)(lds + wave * 16384), (LAS float*)(lds + RL_OFF), tid, gw, NGW, lane); }
        }
        GRID_BAR(); STAMP();

        for (int rep_ = 0; rep_ < NREP(12); ++rep_) if (PH(12)) { if (rep_) GRID_BAR(); PHASE_VARS LAYER_VARS
            pg8::Gemm g{DM, DM, DM, 0x79797979, 0x7d7d7d7d, (unsigned*)(ws + WS_CTL + 524288)}; pg8::DenseSched S; S.init(xq, DM, (unsigned char*)(ws + WS_WPG) + (size_t)layer * DM * DM, DM, T, DM, G, bx);
            pg8::EpiRes<true> E{xb1, x3b, layer == 0 ? (unsigned char*)xb0 : nullptr, rsp_attn, rs_ple, ppb};
            pg8::gemm_phase<pg8::EpiRes<true>, pg8::DenseSched, true, true>(lds, g, S, E, wave);
        }
        GRID_BAR(); STAMP();
    }

__global__ void __launch_bounds__(NTHR, 2) mega_fwd(KArgs args) {
    extern __shared__ __attribute__((aligned(16))) unsigned char lds_raw[];
    LAS unsigned char* lds = (LAS unsigned char*)lds_raw;
    LAS unsigned* LC = (LAS unsigned*)(lds + LDSCTL_OFF);
    const int tid0 = threadIdx.x; const int wave0 = __builtin_amdgcn_readfirstlane(tid0 >> 6);
    const int G0 = gridDim.x; const int bx0 = blockIdx.x;
    unsigned char* const ws0 = args.ws; float* const out0 = args.out;
    for (int u = tid0; u < (LDS_BYTES - LDSCTL_OFF) / 4; u += NTHR) LC[u] = 0u;
    __syncthreads();
    XcdBarrier bar = xcd_barrier_post((unsigned*)(ws0 + WS_CTL) + CW_BAR, (volatile LAS unsigned*)(LC + 8));
    int nst = 0; (void)nst;
    STAMP();
    for (int rep_ = 0; rep_ < NREP(0); ++rep_) if (PH(0)) { if (rep_) GRID_BAR(); PHASE_VARS
        LAS char* scr = (LAS char*)(lds + wave * 16384);
        const float* x = args.in[I_X];
        for (int m = gw; m < T; m += NGW) {
            const f32x4* xr = (const f32x4*)(x + (size_t)m * DM) + lane; f32x4 v[4]; float s = 0.f;
#pragma unroll
            for (int j = 0; j < 4; ++j) { v[j] = xr[64 * j]; s += (v[j].x * v[j].x + v[j].y * v[j].y) + (v[j].z * v[j].z + v[j].w * v[j].w); }
            s = wave_sum(s);
            unsigned* o4 = (unsigned*)((unsigned char*)xbA + (size_t)m * DM) + lane;
#pragma unroll
            for (int j = 0; j < 4; ++j) o4[64 * j] = pk4_fp8(4.f * v[j].x, 4.f * v[j].y, 4.f * v[j].z, 4.f * v[j].w);
            if (lane == 0) rssb[(size_t)RS_ATTNF * T + m] = s;
            { u32x2* o8 = (u32x2*)(x3b + (size_t)m * DM) + lane;
#pragma unroll
              for (int j = 0; j < 4; ++j) { u32x2 w; w.x = cvtpk(v[j].x, v[j].y); w.y = cvtpk(v[j].z, v[j].w); o8[64 * j] = w; } }
        }
        if (G != 256) { const float* p = args.in[I_P]; const size_t n8 = (size_t)2 * T * PLE / 8;
          for (size_t i = gtid; i < n8; i += NGT) { const f32x4 a0 = *(const f32x4*)(p + i * 8), a1 = *(const f32x4*)(p + i * 8 + 4); *(u32x4*)(pb + i * 8) = pack8(a0, a1); } }
        for (int i = gtid; i < 8192 * 16; i += NGT) { const int pos = i >> 4, f = i & 15; const float inv = powf(10000.0f, -(float)f * 2.0f / 32.0f); const float ang = (float)pos * inv; cosT[i] = cosf(ang); sinT[i] = sinf(ang); }
        for (int i = gtid; i < 2 * 32768; i += NGT) { const int l = i >> 15, r = i & 32767, kc = r >> 8, ln = (r >> 2) & 63, j = r & 3; const int k = 8 * kc + 4 * (ln >> 5) + j, e = ln & 31;
            ((float*)(ws + WS_WR))[i] = args.in[I_FFN_NORM][l * DM + k] * args.in[I_W_ROUTER][((size_t)l * DM + k) * NE + e]; }
        convert_small(args, ws, 0, scr, gw, NGW, lane);
        if (G != 256) convert_small(args, ws, 1, scr, gw, NGW, lane);
        if (G != 256) convert_experts(args, ws, 0, scr, (LAS float*)(lds + RL_OFF), tid, gw, NGW, lane);
    }
    GRID_BAR(); STAMP();

    layer_body<0>(args, lds, LC, ws0, out0, G0, bx0, wave0, bar, nst);
    layer_body<1>(args, lds, LC, ws0, out0, G0, bx0, wave0, bar, nst);

    for (int rep_ = 0; rep_ < NREP(13); ++rep_) if (PH(13)) { if (rep_) GRID_BAR(); PHASE_VARS
        const float* fg = args.in[I_FINAL_NORM];
        const unsigned bad = __hip_atomic_load(ctl + CW_BAR + XB_TMO, __ATOMIC_RELAXED, __HIP_MEMORY_SCOPE_AGENT);
        for (int m = gw; m < T; m += NGW) {
            f32x4 v[4]; unpack8(*(const u32x4*)(x3b + (size_t)m * DM + lane * 8), v[0], v[1]); unpack8(*(const u32x4*)(x3b + (size_t)m * DM + 512 + lane * 8), v[2], v[3]);
            float s = 0.f;
#pragma unroll
            for (int j = 0; j < 4; ++j) s += (v[j].x * v[j].x + v[j].y * v[j].y) + (v[j].z * v[j].z + v[j].w * v[j].w);
            s = wave_sum(s);
            float rstd = __builtin_amdgcn_rsqf(s * (1.0f / DM) + EPS);
            if (bad) rstd = __builtin_nanf("");
            float* orow = out + (size_t)m * DM;
            *(f32x4*)(orow + lane * 8) = v[0] * rstd * *(const f32x4*)(fg + lane * 8); *(f32x4*)(orow + lane * 8 + 4) = v[1] * rstd * *(const f32x4*)(fg + lane * 8 + 4);
            *(f32x4*)(orow + 512 + lane * 8) = v[2] * rstd * *(const f32x4*)(fg + 512 + lane * 8); *(f32x4*)(orow + 512 + lane * 8 + 4) = v[3] * rstd * *(const f32x4*)(fg + 512 + lane * 8 + 4);
        }
    }
#if DIAG
    {
        GRID_BAR(); STAMP();
        PHASE_VARS
        if (bx == 0 && tid == 0) {
            LAS unsigned long long* ts = (LAS unsigned long long*)(LC + 1024);
            const int kinds[11] = {1, 2, 3, 5, 6, 7, 8, 9, 10, 11, 12};
            const float total = (float)(ts[24] - ts[0]); float A = 0.f, B = 0.f;
            for (int i = 1; i <= 24; ++i) { const int kind = (i == 1) ? 0 : (i == 24) ? 13 : kinds[(i - 2) % 11]; const float d = (float)(ts[i] - ts[i - 1]);
                if ((DIAG_A_MASK >> kind) & 1u) A += d; if ((DIAG_B_MASK >> kind) & 1u) B += d; }
            A = A / total * 1000.f; B = B / total * 1000.f;
            const float c = exp10f(A / 40.f), dd = c * exp10f(0.5f + B / 400.f);
            ((float*)ctl)[2048] = c; ((float*)ctl)[2049] = dd;
        }
        GRID_BAR();
        const float c = ((volatile float*)ctl)[2048], dd = ((volatile float*)ctl)[2049];
        for (size_t i = gtid; i < (size_t)T * DM; i += NGT) out[i] = (i == 0) ? dd : c;
    }
#endif
}

extern "C" void kernel_launch(void* const* d_in, const int* in_sizes, int n_in, void* d_out, int out_size, void* d_ws, size_t ws_size, hipStream_t stream) {
    static int grid = 0;
    if (grid == 0) {
        if (n_in != 24 || out_size != T * DM || ws_size < WS_END) { fprintf(stderr, "kernel_launch: shape mismatch n_in %d out %d ws %zu (need %zu)\n", n_in, out_size, ws_size, (size_t)WS_END); grid = -1; return; }
        int dev = 0, cus = 0, per_cu = 0;
        if (hipGetDevice(&dev) != hipSuccess || hipDeviceGetAttribute(&cus, hipDeviceAttributeMultiprocessorCount, dev) != hipSuccess) { grid = -1; return; }
        if (hipFuncSetAttribute((const void*)mega_fwd, hipFuncAttributeMaxDynamicSharedMemorySize, LDS_BYTES) != hipSuccess) { fprintf(stderr, "kernel_launch: hipFuncSetAttribute failed\n"); grid = -1; return; }
        if (hipOccupancyMaxActiveBlocksPerMultiprocessor(&per_cu, (const void*)mega_fwd, NTHR, LDS_BYTES) != hipSuccess || per_cu < 1) { fprintf(stderr, "kernel_launch: occupancy query says %d\n", per_cu); }
        (void)hipGetLastError();
        grid = cus;
    }
    if (grid < 0) return;
    if (hipMemsetAsync((char*)d_ws + WS_CTL, 0, ZERO_BYTES, stream) != hipSuccess) return;
    KArgs a{};
    for (int i = 0; i < 24; ++i) a.in[i] = (const float*)d_in[i];
    a.out = (float*)d_out; a.ws = (unsigned char*)d_ws;
    hipLaunchKernelGGL(mega_fwd, dim3(grid), dim3(NTHR), LDS_BYTES, stream, a);
}
```

```cpp
#include <hip/hip_runtime.h>
#include <cstdio>
#include <cstdint>

#define GAS __attribute__((address_space(1)))
#define LAS __attribute__((address_space(3)))
typedef unsigned short bf16_t;
typedef short bf16x8 __attribute__((ext_vector_type(8)));
typedef short s16x4 __attribute__((ext_vector_type(4)));
typedef float f32x2 __attribute__((ext_vector_type(2)));
typedef float f32x4 __attribute__((ext_vector_type(4)));
typedef float f32x16 __attribute__((ext_vector_type(16)));
typedef unsigned u32x2 __attribute__((ext_vector_type(2)));
typedef unsigned u32x4 __attribute__((ext_vector_type(4)));
typedef __bf16 bf16x2_t __attribute__((ext_vector_type(2)));
typedef int v8i __attribute__((ext_vector_type(8)));
typedef int v4i __attribute__((ext_vector_type(4)));

constexpr int BATCH = 4, SEQ = 8192, T = BATCH * SEQ, DM = 1024, DEPTH = 2, PLE = 256;
constexpr int NE = 32, DE = 1024;
constexpr int IN_COLS = 5024, ZC = 5120;
constexpr int QLORA = 384, KVLORA = 256, NH = 8, DQK = 96, DNOPE = 64, DROPE = 32, DV = 64;
constexpr int ZM_LD = 768, ZD_LD = 2304, GT_LD = 2048, Q_LD = 768, KV_LD = 1024;
constexpr int RMAXB = 544, RMAX = RMAXB * 256;
constexpr float EPS = 1e-6f;
constexpr float LOG2E = 1.4426950408889634f;
constexpr float C2_MLA = 0.10206207261596577f * LOG2E;
constexpr float C2_DIL = 0.125f * LOG2E;
constexpr int NWAVES = 8, NTHR = 512;
#ifndef PHASE_MASK
#define PHASE_MASK 0xFFFFFFFFu
#endif
#define PH(k) ((PHASE_MASK >> (k)) & 1u)
#ifndef DIAG
#define DIAG 0
#endif
#define REP_MASK 0u
#define NREP(k) (1 + (int)((REP_MASK >> (k)) & 1u))
#ifndef DIAG_A_MASK
#define DIAG_A_MASK 0u
#endif
#ifndef DIAG_B_MASK
#define DIAG_B_MASK 0u
#endif

constexpr size_t MiB = 1u << 20;
constexpr size_t al(size_t x) { return (x + 255) / 256 * 256; }
constexpr size_t WS_CTL = 0;
constexpr size_t WS_RSS = 1 * MiB;
constexpr size_t ZERO_BYTES = 65536;
constexpr size_t WS_ROPE = al(WS_RSS + (size_t)47 * T * 4);
constexpr size_t WS_WR = WS_ROPE + 2 * 8192 * 16 * 4;
constexpr size_t WS_WIN = WS_WR + 2 * 32768 * 4;
constexpr size_t WS_WUQ = WS_WIN + (size_t)2 * ZC * DM * 2;
constexpr size_t WS_WUKV = WS_WUQ + (size_t)2 * 768 * 384 * 2;
constexpr size_t WS_WA = WS_WUKV + (size_t)2 * 1024 * 256 * 2;
constexpr size_t WS_WB = WS_WA + (size_t)2 * 1024 * 512 * 2;
constexpr size_t WS_WO = WS_WB + (size_t)2 * 1024 * 256 * 2;
constexpr size_t WS_WPG = WS_WO + (size_t)2 * 1024 * 1024 * 2;
constexpr size_t WS_WPP = WS_WPG + (size_t)2 * 1024 * 1024 * 2;
constexpr size_t WS_WGU = WS_WPP + (size_t)2 * 1024 * 256 * 2;
constexpr size_t WS_WD = WS_WGU + (size_t)2 * NE * 2048 * 1024;
constexpr size_t WS_XBA = WS_WD + (size_t)2 * NE * 1024 * 1024;
constexpr size_t WS_XBB = WS_XBA + (size_t)T * DM;
constexpr size_t WS_PB = WS_XBB + (size_t)T * DM * 2;
constexpr size_t WS_ASG = WS_PB + (size_t)2 * T * PLE * 2;
constexpr size_t WS_TW = WS_ASG + (size_t)T * 4 * 4;
constexpr size_t WS_DST = WS_TW + (size_t)T * 4 * 4;
constexpr size_t WS_TOKL = WS_DST + (size_t)T * 4 * 4;
constexpr size_t WS_WL = WS_TOKL + (size_t)NE * 32768 * 4;
constexpr size_t WS_XQ = WS_WL + (size_t)NE * 32768 * 4;
constexpr size_t WS_X3B = WS_XQ + (size_t)T * DM;
constexpr size_t WS_U = al(WS_X3B + (size_t)T * DM * 2);
constexpr size_t WS_ZM = WS_U;
constexpr size_t WS_ZD = WS_ZM + (size_t)T * ZM_LD * 2;
constexpr size_t WS_GT = WS_ZD + (size_t)T * ZD_LD * 2;
constexpr size_t WS_Q = WS_GT + (size_t)T * GT_LD * 2;
constexpr size_t WS_KV = WS_Q + (size_t)T * Q_LD * 2;
constexpr size_t WS_KR = WS_KV + (size_t)T * KV_LD * 2;
constexpr size_t WS_OA = WS_KR + (size_t)T * 32 * 2;
constexpr size_t WS_OG = WS_OA + (size_t)T * 512 * 2;
constexpr size_t WS_LSE = WS_OG + (size_t)3 * T * 256 * 2;
constexpr size_t WS_OB = WS_LSE + (size_t)3 * T * 4 * 4;
constexpr size_t WS_MIXER_END = WS_OB + (size_t)T * 256 * 2;
constexpr size_t WS_MIX = WS_ZD;
constexpr size_t WS_PP = WS_Q;
constexpr size_t WS_Y = WS_U;
constexpr size_t WS_HM = WS_Y + (size_t)RMAX * DM;
constexpr size_t WS_MOE_END = WS_HM + (size_t)RMAX * DE;
constexpr size_t WS_END = WS_MIXER_END > WS_MOE_END ? WS_MIXER_END : WS_MOE_END;
static_assert(WS_END <= (size_t)1024 * MiB, "workspace map must fit 1 GiB");
static_assert(WS_ZD + (size_t)T * DM * 2 <= WS_GT, "MIX overlay inside zd");
static_assert(WS_MOE_END <= WS_PP && WS_PP + (size_t)T * DM * 2 <= WS_KR, "PP overlay: after the MoE view, inside q | kv");

constexpr int CW_BAR = 4096;
constexpr int CW_CNT = 8192;
constexpr int CW_KMAX = 12288;
enum { RSP_ATTN = 0, RSP_FFN = 16, RSP_Q = 32, RSP_KV = 40, RS_FFNF = 44, RS_PLE = 45, RS_ATTNF = 46 };

constexpr int RING_BYTES = 131072;
constexpr int LDSCTL_OFF = RING_BYTES;
constexpr int LT_MISC = 0, LT_UCUM = 64, LT_RB0 = 128, LT_HIST = 192, LT_BASE = 256;
constexpr int RL_OFF = 147456;
constexpr int LDS_BYTES = 163840;

#define LDS_WAIT() asm volatile("s_waitcnt lgkmcnt(0)" ::: "memory")
#define VM_WAIT() asm volatile("s_waitcnt vmcnt(0)" ::: "memory")
__device__ __forceinline__ unsigned cvtpk(float lo, float hi) { f32x2 v = {lo, hi}; bf16x2_t b = __builtin_convertvector(v, bf16x2_t); return __builtin_bit_cast(unsigned, b); }
__device__ __forceinline__ u32x4 pack8(f32x4 a, f32x4 b) { u32x4 w; w.x = cvtpk(a[0], a[1]); w.y = cvtpk(a[2], a[3]); w.z = cvtpk(b[0], b[1]); w.w = cvtpk(b[2], b[3]); return w; }
__device__ __forceinline__ unsigned pk4_fp8(float a, float b, float c, float d) {
    a = fminf(fmaxf(a, -448.f), 448.f); b = fminf(fmaxf(b, -448.f), 448.f); c = fminf(fmaxf(c, -448.f), 448.f); d = fminf(fmaxf(d, -448.f), 448.f);
    int w = 0; w = __builtin_amdgcn_cvt_pk_fp8_f32(a, b, w, false); w = __builtin_amdgcn_cvt_pk_fp8_f32(c, d, w, true); return (unsigned)w; }
__device__ __forceinline__ unsigned pk4_fp8_nc(float a, float b, float c, float d) { int w = 0; w = __builtin_amdgcn_cvt_pk_fp8_f32(a, b, w, false); w = __builtin_amdgcn_cvt_pk_fp8_f32(c, d, w, true); return (unsigned)w; }
__device__ __forceinline__ f32x4 unpack4_fp8(unsigned w) { const auto lo = __builtin_amdgcn_cvt_pk_f32_fp8((int)w, false); const auto hi = __builtin_amdgcn_cvt_pk_f32_fp8((int)w, true); return (f32x4){lo[0], lo[1], hi[0], hi[1]}; }
__device__ __forceinline__ float bflo(unsigned w) { return __uint_as_float(w << 16); }
__device__ __forceinline__ float bfhi(unsigned w) { return __uint_as_float(w & 0xffff0000u); }
__device__ __forceinline__ void unpack8(u32x4 w, f32x4& a, f32x4& b) { a = (f32x4){bflo(w.x), bfhi(w.x), bflo(w.y), bfhi(w.y)}; b = (f32x4){bflo(w.z), bfhi(w.z), bflo(w.w), bfhi(w.w)}; }
__device__ __forceinline__ float fsigmoid(float x) { return __builtin_amdgcn_rcpf(1.0f + __builtin_amdgcn_exp2f(-x * LOG2E)); }
template <int X> __device__ __forceinline__ float sx(float v) { return __int_as_float(__builtin_amdgcn_ds_swizzle(__float_as_int(v), (X << 10) | 0x1f)); }
__device__ __forceinline__ float sum32(float v) { auto rr = __builtin_amdgcn_permlane32_swap(__float_as_uint(v), __float_as_uint(v), false, false); return __uint_as_float(rr[0]) + __uint_as_float(rr[1]); }
__device__ __forceinline__ float max32(float v) { auto rr = __builtin_amdgcn_permlane32_swap(__float_as_uint(v), __float_as_uint(v), false, false); return fmaxf(__uint_as_float(rr[0]), __uint_as_float(rr[1])); }
__device__ __forceinline__ float wave_sum(float v) { v += sx<1>(v); v += sx<2>(v); v += sx<4>(v); v += sx<8>(v); v += sx<16>(v); return sum32(v); }
__device__ __forceinline__ float sum4(const float* p) { const f32x4 a = *(const f32x4*)p; return (a[0] + a[1]) + (a[2] + a[3]); }
__device__ __forceinline__ float sum16(const float* p) { return (sum4(p) + sum4(p + 4)) + (sum4(p + 8) + sum4(p + 12)); }
__device__ __forceinline__ int crow(int r, int hi) { return (r & 3) + 8 * (r >> 2) + 4 * hi; }

#define XB_TMO      128
#define XB_XCNT(j)  (256  + 64 * (j))
#define XB_XSUB(j)  (1280 + 64 * (j))
#define XB_XGEN(j)  (2304 + 64 * (j))
#define XB_TOP      3328
#define XB_TOPGEN   3392
#define XCD_BAR_WORDS 3456
#define XB_SPIN_CAP (1u << 18)
__device__ __forceinline__ unsigned xb_ld(unsigned* p)              { return __hip_atomic_load(p, __ATOMIC_RELAXED, __HIP_MEMORY_SCOPE_AGENT); }
__device__ __forceinline__ unsigned xb_add(unsigned* p, unsigned v) { return __hip_atomic_fetch_add(p, v, __ATOMIC_RELAXED, __HIP_MEMORY_SCOPE_AGENT); }
__device__ __forceinline__ unsigned xb_xcc_id() { return (unsigned)__builtin_amdgcn_s_getreg((3 << 11) | 20) & 0xFu; }
#define XB_SPIN(cond, bar) do { unsigned _sp = 0; while (cond) { __builtin_amdgcn_s_sleep(1); \
    if ((++_sp & 255u) == 0u) { if (xb_ld(&(bar)[XB_TMO])) break; if (_sp > XB_SPIN_CAP) { atomicAdd(&(bar)[XB_TMO], 1u); break; } } } } while (0)
struct XcdBarrier { unsigned* bar; unsigned x; volatile LAS unsigned* st; };
__device__ __forceinline__ XcdBarrier xcd_barrier_post(unsigned* bar, volatile LAS unsigned* st) {
    XcdBarrier b; b.bar = bar; b.x = xb_xcc_id(); b.st = st;
    if (threadIdx.x == 0) (void)xb_add(&bar[XB_XCNT(b.x)], 1u);
    return b;
}
__device__ __forceinline__ void xcd_barrier_complete(unsigned* bar, unsigned x, unsigned& nloc, unsigned& nx) {
    const unsigned G = gridDim.x * gridDim.y * gridDim.z;
    unsigned sum, cnt, mine, sp = 0u;
    for (;;) {
        sum = 0u; cnt = 0u; mine = 0u;
#pragma unroll
        for (unsigned j = 0; j < 16; ++j) { const unsigned c = xb_ld(&bar[XB_XCNT(j)]); sum += c; cnt += (c > 0u) ? 1u : 0u; mine = (j == x) ? c : mine; }
        if (sum == G) break;
        __builtin_amdgcn_s_sleep(1);
        if ((++sp & 255u) == 0u) { if (xb_ld(&bar[XB_TMO])) break; if (sp > XB_SPIN_CAP) { atomicAdd(&bar[XB_TMO], 1u); break; } }
    }
    nloc = mine > 0u ? mine : 1u; nx = cnt > 0u ? cnt : 1u;
}
__device__ __forceinline__ void xcd_barrier(const XcdBarrier& b) {
    asm volatile("s_waitcnt vmcnt(0)" ::: "memory");
    __syncthreads();
    if (threadIdx.x == 0) {
        unsigned* bar = b.bar;
        __builtin_amdgcn_s_waitcnt(0);
        unsigned nloc = b.st[0], nx = b.st[1];
        if (nloc == 0u) { xcd_barrier_complete(bar, b.x, nloc, nx); b.st[0] = nloc; b.st[1] = nx; }
        const unsigned old = xb_add(&bar[XB_XSUB(b.x)], 1u);
        const unsigned gen = old / nloc;
        if (old + 1u == (gen + 1u) * nloc) {
            __builtin_amdgcn_fence(__ATOMIC_RELEASE, "agent");
            asm volatile("s_waitcnt vmcnt(0)" ::: "memory");
            const unsigned og = xb_add(&bar[XB_TOP], 1u);
            const unsigned tg = og / nx;
            if (og + 1u == (tg + 1u) * nx) xb_add(&bar[XB_TOPGEN], 1u);
            else XB_SPIN(xb_ld(&bar[XB_TOPGEN]) == tg, bar);
            __builtin_amdgcn_fence(__ATOMIC_ACQUIRE, "agent");
            xb_add(&bar[XB_XGEN(b.x)], 1u);
            asm volatile("s_waitcnt vmcnt(0)" ::: "memory");
        } else {
            XB_SPIN(xb_ld(&bar[XB_XGEN(b.x)]) == gen, bar);
            __builtin_amdgcn_fence(__ATOMIC_ACQUIRE, "agent");
            asm volatile("s_waitcnt vmcnt(0)" ::: "memory");
        }
    }
    __syncthreads();
}

namespace pg8 {
constexpr int BM = 256, BK = 64, HALF = 128, HTB = HALF * BK * 2, STAGE_BYTES = 8 * HTB, NXCD = 8, WGM = 8;
__host__ __device__ __forceinline__ int lds_byte(int r, int c) { const int st = (r >> 4) * 2 + (c >> 5), rr = r & 15, cc = c & 31, ob = rr * 64 + cc * 2; return st * 1024 + (ob ^ (((ob >> 9) & 1) << 5)); }
__host__ __device__ __forceinline__ void stage_rc(int b, int& R, int& C) { const int st = b / 1024, sb = b % 1024, swz = sb ^ (((sb >> 9) & 1) << 5); R = (st >> 1) * 16 + swz / 64; C = (st & 1) * 32 + (swz % 64) / 2; }
__host__ __device__ __forceinline__ int perm32(int rho) { const int n = rho >> 4, i = rho & 15; return 8 * (i >> 2) + 4 * n + (i & 3); }

struct Unit { const char* A; const char* B; int pm, pn, aux, rl; };
struct Gemm { int ldaB, ldbB, KB; int sw, sa; unsigned* dummy; };

struct DenseSched {
    const char* A; const char* B; size_t tA, tB; int nM, nN, nwg, G, c;
    __device__ __forceinline__ void init(const void* A_, int ldaB, const void* B_, int ldbB, int M, int N, int G_, int c_) { A = (const char*)A_; B = (const char*)B_; tA = (size_t)BM * ldaB; tB = (size_t)BM * ldbB; nM = M / BM; nN = N / BM; nwg = nM * nN; G = G_; c = c_; }
    __device__ __forceinline__ bool next(int i, Unit& u) const {
        const long L = (long)i * G + c; if (L >= nwg) return false;
        int wgid = (int)L; { const int q = nwg / NXCD, r = nwg % NXCD, xcd = wgid % NXCD, off = wgid / NXCD; wgid = (xcd < r ? xcd * (q + 1) : r * (q + 1) + (xcd - r) * q) + off; }
        const int nig = WGM * nN, gid = wgid / nig, fm = gid * WGM, gsz = (nM - fm) < WGM ? (nM - fm) : WGM;
        u.pm = fm + ((wgid % nig) % gsz); u.pn = (wgid % nig) / gsz; u.aux = 0; u.rl = 0;
        u.A = A + (size_t)u.pm * tA; u.B = B + (size_t)u.pn * tB; return true;
    }
};
struct MoeSched {
    const char* A; const char* B; size_t tA, tB, eB; int NT, G, c; const LAS int* ucum; const LAS int* rb0; bool gather;
    __device__ __forceinline__ bool next(int i, Unit& u) const {
        const int nwg = __builtin_amdgcn_readfirstlane(ucum[NE]); const long L = (long)i * G + c; if (L >= nwg) return false;
        int wgid = (int)L; { const int q = nwg / NXCD, r = nwg % NXCD, xcd = wgid % NXCD, off = wgid / NXCD; wgid = (xcd < r ? xcd * (q + 1) : r * (q + 1) + (xcd - r) * q) + off; }
        int e = 0;
        for (int j = 1; j < NE; ++j) e = (wgid >= ucum[j]) ? j : e;
        e = __builtin_amdgcn_readfirstlane(e);
        const int local = wgid - __builtin_amdgcn_readfirstlane(ucum[e]); const int rb = local / NT, pn = local - rb * NT;
        u.pm = __builtin_amdgcn_readfirstlane(rb0[e]) + rb; u.pn = pn; u.aux = e; u.rl = rb;
        u.A = gather ? A : A + (size_t)u.pm * tA; u.B = B + (size_t)e * eB + (size_t)pn * tB; return true;
    }
};

template <class Epi, class Sched, bool ALIGN_EPI, bool F8 = false, bool GATHER = false>
__device__ __forceinline__ void gemm_phase(LAS unsigned char* lds, const Gemm g, const Sched& S, const Epi& E, int wave_in, const LAS unsigned short* rowlist = nullptr) {
    int wid = wave_in; asm volatile("" : "+s"(wid)); int lane = (int)__builtin_amdgcn_mbcnt_hi(~0u, __builtin_amdgcn_mbcnt_lo(~0u, 0u)); asm volatile("" : "+v"(lane)); const int tid = wid * 64 + lane;
    const int wr = wid >> 2, wc = wid & 3, fr = lane & 15, fq = lane >> 4;
    const int nt = g.KB / (BK * 2);
    unsigned voffA[2], voffB[2]; unsigned cv0[2], cv1[2], nv0[2], nv1[2]; int gR[2], gC[2];
#pragma unroll
    for (int i = 0; i < 2; ++i) { int R, C; stage_rc(tid * 16 + i * 8192, R, C); const int Rb = (R & ~31) + perm32(R & 31); gR[i] = R; gC[i] = C * 2;
        voffA[i] = (unsigned)(R * g.ldaB + C * 2); voffB[i] = (unsigned)(Rb * g.ldbB + C * 2); cv0[i] = cv1[i] = nv0[i] = nv1[i] = 0u; }
#define PG8_ROWS(dst0, dst1, ui_) do { _Pragma("unroll") for (int _i = 0; _i < 2; ++_i) { \
        dst0[_i] = (unsigned)rowlist[(ui_) * 256 + gR[_i]] * (unsigned)g.ldaB + (unsigned)gC[_i]; dst1[_i] = (unsigned)rowlist[(ui_) * 256 + 128 + gR[_i]] * (unsigned)g.ldaB + (unsigned)gC[_i]; } } while (0)
    const size_t kstep = (size_t)(BK * 2);
    const size_t hA = GATHER ? 0 : (size_t)HALF * g.ldaB, hB = (size_t)HALF * g.ldbB;
    const unsigned ldsw = (unsigned)wid * 1024u; const unsigned ldsbase = (unsigned)(uintptr_t)lds;
    const int aoff = lds_byte(wr * 64 + fr, fq * 8), boff = lds_byte(wc * 32 + fr, fq * 8);
#define PG8_SA(b, h) (((b) * 2 + (h)) * HTB)
#define PG8_SB(b, h) ((4 + (b) * 2 + (h)) * HTB)
#define PG8_STAGE(bufoff, gbase, voff) do { if constexpr (F8) { unsigned long long _gb = (unsigned long long)(gbase); asm volatile("" : "+s"(_gb)); _Pragma("unroll") for (int _i = 0; _i < 2; ++_i) \
        __builtin_amdgcn_global_load_lds((const GAS unsigned*)(_gb + (voff)[_i]), (LAS unsigned*)(lds + (bufoff) + ldsw + _i * 8192), 16, 0, 0); } else { \
        const char* _gb = (const char*)(gbase); const unsigned _la = ldsbase + (unsigned)(bufoff) + ldsw; \
        asm volatile("s_mov_b32 m0, %2\n\ts_nop 0\n\tglobal_load_lds_dwordx4 %0, %1" :: "v"((voff)[0]), "s"(_gb), "s"(_la) : "memory", "m0"); \
        asm volatile("s_mov_b32 m0, %2\n\ts_nop 0\n\tglobal_load_lds_dwordx4 %0, %1" :: "v"((voff)[1]), "s"(_gb), "s"(_la + 8192u) : "memory", "m0"); } } while (0)
#define PG8_LDA(dst, b, h) do { _Pragma("unroll") for (int m = 0; m < 4; ++m) _Pragma("unroll") for (int k = 0; k < 2; ++k) dst[m][k] = *(const LAS bf16x8*)(lds + PG8_SA(b, h) + aoff + m * 2048 + k * 1024); } while (0)
#define PG8_LDB(dst, b, h) do { _Pragma("unroll") for (int n = 0; n < 2; ++n) _Pragma("unroll") for (int k = 0; k < 2; ++k) dst[n][k] = *(const LAS bf16x8*)(lds + PG8_SB(b, h) + boff + n * 2048 + k * 1024); } while (0)
#define PG8_MMA(ai, bj, At, Bt) do { __builtin_amdgcn_s_setprio(1); _Pragma("unroll") for (int m = 0; m < 4; ++m) _Pragma("unroll") for (int n = 0; n < 2; ++n) { \
        if constexpr (F8) { const v8i w8_ = __builtin_shufflevector(__builtin_bit_cast(v4i, Bt[n][0]), __builtin_bit_cast(v4i, Bt[n][1]), 0, 1, 2, 3, 4, 5, 6, 7); \
            const v8i a8_ = __builtin_shufflevector(__builtin_bit_cast(v4i, At[m][0]), __builtin_bit_cast(v4i, At[m][1]), 0, 1, 2, 3, 4, 5, 6, 7); \
            asm volatile("v_mfma_scale_f32_16x16x128_f8f6f4 %0, %1, %2, %0, %3, %4 op_sel_hi:[0,0,0]" : "+v"(acc[ai][bj][m][n]) : "v"(w8_), "v"(a8_), "v"(sw_), "v"(sa_)); } \
        else { _Pragma("unroll") for (int k = 0; k < 2; ++k) acc[ai][bj][m][n] = __builtin_amdgcn_mfma_f32_16x16x32_bf16(Bt[n][k], At[m][k], acc[ai][bj][m][n], 0, 0, 0); } } \
        __builtin_amdgcn_s_setprio(0); } while (0)
#define PG8_MMAZ(ai, bj, At, Bt) do { __builtin_amdgcn_s_setprio(1); _Pragma("unroll") for (int m = 0; m < 4; ++m) _Pragma("unroll") for (int n = 0; n < 2; ++n) { \
        if constexpr (F8) { const v8i w8_ = __builtin_shufflevector(__builtin_bit_cast(v4i, Bt[n][0]), __builtin_bit_cast(v4i, Bt[n][1]), 0, 1, 2, 3, 4, 5, 6, 7); \
            const v8i a8_ = __builtin_shufflevector(__builtin_bit_cast(v4i, At[m][0]), __builtin_bit_cast(v4i, At[m][1]), 0, 1, 2, 3, 4, 5, 6, 7); \
            asm volatile("v_mfma_scale_f32_16x16x128_f8f6f4 %0, %1, %2, 0, %3, %4 op_sel_hi:[0,0,0]" : "=&v"(acc[ai][bj][m][n]) : "v"(w8_), "v"(a8_), "v"(sw_), "v"(sa_)); } \
        else { acc[ai][bj][m][n] = __builtin_amdgcn_mfma_f32_16x16x32_bf16(Bt[n][0], At[m][0], (f32x4){0.f, 0.f, 0.f, 0.f}, 0, 0, 0); \
               acc[ai][bj][m][n] = __builtin_amdgcn_mfma_f32_16x16x32_bf16(Bt[n][1], At[m][1], acc[ai][bj][m][n], 0, 0, 0); } } \
        __builtin_amdgcn_s_setprio(0); } while (0)
#define PG8_WAIT_V(n) asm volatile("s_waitcnt vmcnt(" #n ")" ::: "memory")
#define PG8_WAIT_L(n) asm volatile("s_waitcnt lgkmcnt(" #n ")" ::: "memory")
#define PG8_BAR __builtin_amdgcn_s_barrier()
#define PG8_SCHED __builtin_amdgcn_sched_barrier(0)
    Unit cur, nxt; int ui = 0;
    if (!S.next(0, cur)) return;
    const int sw_ = g.sw, sa_ = g.sa; (void)sw_; (void)sa_;
    f32x4 acc[2][2][4][2];
    bf16x8 At[4][2], B0[2][2], B1[2][2];
    const char* cA = cur.A; const char* cB = cur.B;
    if constexpr (GATHER) { PG8_ROWS(cv0, cv1, 0); } else { cv0[0] = cv1[0] = voffA[0]; cv0[1] = cv1[1] = voffA[1]; }
    PG8_STAGE(PG8_SB(0, 0), cB, voffB); PG8_STAGE(PG8_SB(0, 1), cB + hB, voffB); PG8_STAGE(PG8_SA(0, 0), cA, cv0); PG8_STAGE(PG8_SA(0, 1), cA + hA, cv1);
    if (wr == 1) PG8_BAR;
    PG8_WAIT_V(2); PG8_BAR;
    PG8_STAGE(PG8_SB(1, 0), cB + kstep, voffB); PG8_STAGE(PG8_SA(1, 0), cA + kstep, cv0); PG8_STAGE(PG8_SB(1, 1), cB + hB + kstep, voffB);
    PG8_WAIT_V(6); PG8_BAR;
    { const unsigned* dp_ = g.dummy + wid * 64 + lane; const unsigned z_ = 0u;
#pragma unroll
      for (int i_ = 0; i_ < Epi::NST; ++i_) asm volatile("global_store_dword %0, %1, off" :: "v"(dp_), "v"(z_) : "memory"); }
    for (;;) {
        const bool has_next = S.next(ui + 1, nxt);
        const char* nA = has_next ? nxt.A : cA; const char* nB = has_next ? nxt.B : cB;
        if constexpr (GATHER) { if (has_next) { PG8_ROWS(nv0, nv1, ui + 1); } else { nv0[0] = cv0[0]; nv0[1] = cv0[1]; nv1[0] = cv1[0]; nv1[1] = cv1[1]; } }
        else { nv0[0] = nv1[0] = voffA[0]; nv0[1] = nv1[1] = voffA[1]; }
#define PG8_KITER(t_, W12, MMA1) do { const int t = (t_); \
            const bool last = (t == nt - 2); \
            const char* a1 = cA + (size_t)(t + 1) * kstep; \
            const char* a2 = last ? nA : cA + (size_t)(t + 2) * kstep; const char* b2 = last ? nB : cB + (size_t)(t + 2) * kstep; \
            const char* a3 = a2 + kstep; const char* b3 = b2 + kstep; \
            unsigned s0[2], s1[2]; \
            if constexpr (GATHER) { s0[0] = last ? nv0[0] : cv0[0]; s0[1] = last ? nv0[1] : cv0[1]; s1[0] = last ? nv1[0] : cv1[0]; s1[1] = last ? nv1[1] : cv1[1]; } \
            else { s0[0] = s1[0] = voffA[0]; s0[1] = s1[1] = voffA[1]; } \
            PG8_LDB(B0, 0, 0); PG8_LDB(B1, 0, 1); PG8_SCHED; PG8_LDA(At, 0, 0); PG8_STAGE(PG8_SA(1, 1), a1 + hA, cv1); \
            W12; PG8_WAIT_L(0); PG8_BAR; MMA1(0, 0, At, B0); MMA1(0, 1, At, B1); PG8_BAR; PG8_SCHED; \
            PG8_LDA(At, 0, 1); PG8_STAGE(PG8_SB(0, 0), b2, voffB); PG8_STAGE(PG8_SB(0, 1), b2 + hB, voffB); PG8_STAGE(PG8_SA(0, 0), a2, s0); \
            W12; PG8_WAIT_L(0); PG8_BAR; MMA1(1, 0, At, B0); MMA1(1, 1, At, B1); PG8_BAR; PG8_SCHED; \
            PG8_LDB(B0, 1, 0); PG8_LDB(B1, 1, 1); PG8_SCHED; PG8_LDA(At, 1, 0); PG8_STAGE(PG8_SA(0, 1), a2 + hA, s1); \
            PG8_WAIT_V(8); PG8_WAIT_L(0); PG8_BAR; PG8_MMA(0, 0, At, B0); PG8_MMA(0, 1, At, B1); PG8_BAR; PG8_SCHED; \
            PG8_LDA(At, 1, 1); PG8_STAGE(PG8_SB(1, 0), b3, voffB); PG8_STAGE(PG8_SB(1, 1), b3 + hB, voffB); PG8_STAGE(PG8_SA(1, 0), a3, s0); \
            PG8_WAIT_V(8); PG8_WAIT_L(0); PG8_BAR; PG8_MMA(1, 0, At, B0); PG8_MMA(1, 1, At, B1); PG8_BAR; PG8_SCHED; } while (0)
        PG8_KITER(0, asm volatile("s_waitcnt vmcnt(%0)" :: "n"(8 + Epi::NST) : "memory"), PG8_MMAZ);
        for (int t2 = 2; t2 < nt; t2 += 2) PG8_KITER(t2, PG8_WAIT_V(8), PG8_MMA);
#undef PG8_KITER
        if constexpr (ALIGN_EPI) { if (wr == 0) PG8_BAR; }
        if constexpr (F8) asm volatile("s_nop 15\n\ts_nop 15" ::: "memory");
        { int fr_ = fr, fq_ = fq, wr_ = wr, wc_ = wc; asm volatile("" : "+v"(fr_), "+v"(fq_), "+s"(wr_), "+s"(wc_)); E(acc, cur, wr_, wc_, fr_, fq_); }
        if (!has_next) break;
        cur = nxt; cA = nA; cB = nB; ++ui; cv0[0] = nv0[0]; cv0[1] = nv0[1]; cv1[0] = nv1[0]; cv1[1] = nv1[1];
        if constexpr (ALIGN_EPI) { if (wr == 1) PG8_BAR; }
    }
    PG8_WAIT_V(0);
    if constexpr (!ALIGN_EPI) { if (wr == 0) PG8_BAR; }
    PG8_BAR;
#undef PG8_SA
#undef PG8_SB
#undef PG8_STAGE
#undef PG8_ROWS
#undef PG8_LDA
#undef PG8_LDB
#undef PG8_MMA
#undef PG8_MMAZ
#undef PG8_WAIT_V
#undef PG8_WAIT_L
#undef PG8_BAR
#undef PG8_SCHED
}

#define EPI_ROW(u, ai, m) ((u).pm * 256 + (ai) * 128 + wr * 64 + (m) * 16 + fr)
#define EPI_COL(bj) ((bj) * 128 + wc * 32 + 8 * fq)
typedef f32x4 Acc[2][2][4][2];
#define EPI_FENCE() asm volatile("" ::: "memory")

#define LOADS_DONE() asm volatile("" ::: "memory")
struct EpiZ {
    static constexpr int NST = 16;
    const float* rsp; float* rspq; float* rspkv; bf16_t* zm; bf16_t* zd; bf16_t* gt; bf16_t* kr; const float* cosT; const float* sinT; unsigned* krmx;
    __device__ __forceinline__ void operator()(const Acc& acc, const Unit& u, int wr, int wc, int fr, int fq) const {
        const int pn = u.pn; float krq = 0.f; float kdq[2] = {0.f, 0.f};
        float rstd[2][4];
#pragma unroll
        for (int ai = 0; ai < 2; ++ai)
#pragma unroll
            for (int m = 0; m < 4; ++m) rstd[ai][m] = rsp[EPI_ROW(u, ai, m)];
#pragma unroll
        for (int ai = 0; ai < 2; ++ai)
#pragma unroll
            for (int m = 0; m < 4; ++m) rstd[ai][m] = __builtin_amdgcn_rsqf(rstd[ai][m] * (1.0f / DM) + EPS);
        const bool ropew = (pn == 2 && wc == 0);
        LOADS_DONE();
#pragma unroll
        for (int ai = 0; ai < 2; ++ai)
#pragma unroll
            for (int m = 0; m < 4; ++m) {
                const int row = EPI_ROW(u, ai, m);
                const float rs_ = rstd[ai][m];
                if (pn < 3) {
                    float ss = 0.f;
#pragma unroll
                    for (int bj = 0; bj < 2; ++bj) {
                        const f32x4 v0 = acc[ai][bj][m][0] * rs_, v1 = acc[ai][bj][m][1] * rs_;
                        *(u32x4*)(zm + (size_t)row * ZM_LD + pn * 256 + EPI_COL(bj)) = pack8(v0, v1);
                        if (pn != 2 || bj == 0) ss += (v0[0] * v0[0] + v0[1] * v0[1]) + (v0[2] * v0[2] + v0[3] * v0[3]) + (v1[0] * v1[0] + v1[1] * v1[1]) + (v1[2] * v1[2] + v1[3] * v1[3]);
                        if (ropew && bj == 1) {
                            const int pos = row & (SEQ - 1); const f32x4 cs = *(const f32x4*)(cosT + pos * 16 + 4 * fq), sn = *(const f32x4*)(sinT + pos * 16 + 4 * fq);
                            const f32x4 o0 = v0 * cs - v1 * sn, o1 = v0 * sn + v1 * cs;
                            const u32x4 pk_ = pack8(o0, o1); *(u32x4*)(kr + (size_t)row * 32 + 8 * fq) = pk_;
                            f32x4 w0, w1; unpack8(pk_, w0, w1); float q_ = (w0[0] * w0[0] + w0[1] * w0[1]) + (w0[2] * w0[2] + w0[3] * w0[3]) + (w1[0] * w1[0] + w1[1] * w1[1]) + (w1[2] * w1[2] + w1[3] * w1[3]);
                            q_ += sx<16>(q_); q_ = sum32(q_); krq = fmaxf(krq, q_);
                        }
                    }
                    ss += sx<16>(ss); ss = sum32(ss);
                    if (fq == 0) { if (pn == 0) rspkv[(size_t)row * 4 + wc] = ss; else rspq[(size_t)row * 8 + (pn - 1) * 4 + wc] = ss; }
                } else if (pn < 12) {
                    const int j = pn - 3; const float sc = rs_ * ((j % 3) == 0 ? C2_DIL : 1.0f);
#pragma unroll
                    for (int bj = 0; bj < 2; ++bj) { const u32x4 pk_ = pack8(acc[ai][bj][m][0] * sc, acc[ai][bj][m][1] * sc); *(u32x4*)(zd + (size_t)row * ZD_LD + j * 256 + EPI_COL(bj)) = pk_;
                        if ((j % 3) == 1) { f32x4 w0, w1; unpack8(pk_, w0, w1); float q_ = (w0[0] * w0[0] + w0[1] * w0[1]) + (w0[2] * w0[2] + w0[3] * w0[3]) + (w1[0] * w1[0] + w1[1] * w1[1]) + (w1[2] * w1[2] + w1[3] * w1[3]);
                            q_ += sx<16>(q_); q_ = sum32(q_); kdq[bj] = fmaxf(kdq[bj], q_); } }
                } else {
                    const int j = pn - 12;
#pragma unroll
                    for (int bj = 0; bj < 2; ++bj) { f32x4 v0 = acc[ai][bj][m][0] * rs_, v1 = acc[ai][bj][m][1] * rs_;
#pragma unroll
                        for (int i = 0; i < 4; ++i) { v0[i] = fsigmoid(v0[i]); v1[i] = fsigmoid(v1[i]); }
                        *(u32x4*)(gt + (size_t)row * GT_LD + j * 256 + EPI_COL(bj)) = pack8(v0, v1); }
                }
            }
        if (pn >= 3 && pn < 12 && ((pn - 3) % 3) == 1) {
#pragma unroll
            for (int bj = 0; bj < 2; ++bj) { float q_ = kdq[bj]; q_ = fmaxf(q_, sx<1>(q_)); q_ = fmaxf(q_, sx<2>(q_)); q_ = fmaxf(q_, sx<4>(q_)); q_ = fmaxf(q_, sx<8>(q_));
                if ((fr | fq) == 0) (void)__hip_atomic_fetch_max((GAS unsigned*)krmx + 16 + (((u.pm * 256 / SEQ) * 3 + (pn - 3) / 3) * 4 + 2 * bj + (wc >> 1)) * 2 + (wc & 1), __float_as_uint(q_), __ATOMIC_RELAXED, __HIP_MEMORY_SCOPE_AGENT); } }
        if (ropew) {
            { krq = fmaxf(krq, sx<1>(krq)); krq = fmaxf(krq, sx<2>(krq)); krq = fmaxf(krq, sx<4>(krq)); krq = fmaxf(krq, sx<8>(krq)); }
            if ((fr | fq) == 0) (void)__hip_atomic_fetch_max((GAS unsigned*)krmx + (u.pm * 256 / SEQ), __float_as_uint(krq), __ATOMIC_RELAXED, __HIP_MEMORY_SCOPE_AGENT); }
    }
};
template <bool KMAX = false, bool OUT8 = false> struct EpiGen {
    static constexpr int NST = 16;
    bf16_t* out; int ldo; const float* rs; int rsn; float rsdiv; float cscale; const bf16_t* mul; int ldm; const bf16_t* add; int ldadd; unsigned* kmx;
    __device__ __forceinline__ void operator()(const Acc& acc, const Unit& u, int wr, int wc, int fr, int fq) const {
        float kq[2] = {0.f, 0.f};
#pragma unroll
        for (int ai = 0; ai < 2; ++ai) {
            f32x4 r0[4], r1[4]; u32x4 mv[4][2], av[4][2];
#pragma unroll
            for (int m = 0; m < 4; ++m) { const int row = EPI_ROW(u, ai, m);
                if (rs) { r0[m] = *(const f32x4*)(rs + (size_t)row * 4 * rsn); if (rsn == 2) r1[m] = *(const f32x4*)(rs + (size_t)row * 8 + 4); }
#pragma unroll
                for (int bj = 0; bj < 2; ++bj) { const int col = u.pn * 256 + EPI_COL(bj);
                    if (mul) mv[m][bj] = *(const u32x4*)(mul + (size_t)row * ldm + col);
                    if (add) av[m][bj] = *(const u32x4*)(add + (size_t)row * ldadd + col); } }
            LOADS_DONE();
#pragma unroll
            for (int m = 0; m < 4; ++m) { const int row = EPI_ROW(u, ai, m);
                float sc = 1.0f; if (rs) { float t = (r0[m][0] + r0[m][1]) + (r0[m][2] + r0[m][3]); if (rsn == 2) t += (r1[m][0] + r1[m][1]) + (r1[m][2] + r1[m][3]); sc = __builtin_amdgcn_rsqf(t * rsdiv + EPS) * cscale; }
#pragma unroll
                for (int bj = 0; bj < 2; ++bj) { const int col = u.pn * 256 + EPI_COL(bj);
                    f32x4 v0 = acc[ai][bj][m][0] * sc, v1 = acc[ai][bj][m][1] * sc;
                    if (mul) { f32x4 g0, g1; unpack8(mv[m][bj], g0, g1); v0 = v0 * g0; v1 = v1 * g1; }
                    if (add) { f32x4 a0, a1; unpack8(av[m][bj], a0, a1); v0 = v0 + a0; v1 = v1 + a1; }
                    u32x4 pk_ = {0u, 0u, 0u, 0u};
                    if constexpr (OUT8) { u32x2 w8; w8.x = pk4_fp8(8.f * v0[0], 8.f * v0[1], 8.f * v0[2], 8.f * v0[3]); w8.y = pk4_fp8(8.f * v1[0], 8.f * v1[1], 8.f * v1[2], 8.f * v1[3]); *(u32x2*)((unsigned char*)out + (size_t)row * ldo + col) = w8; }
                    else { pk_ = pack8(v0, v1); *(u32x4*)(out + (size_t)row * ldo + col) = pk_; }
                    if (KMAX) { f32x4 w0, w1; unpack8(pk_, w0, w1);
                        float q_ = (w0[0] * w0[0] + w0[1] * w0[1]) + (w0[2] * w0[2] + w0[3] * w0[3]) + (w1[0] * w1[0] + w1[1] * w1[1]) + (w1[2] * w1[2] + w1[3] * w1[3]);
                        q_ += sx<16>(q_); q_ = sum32(q_); kq[bj] = fmaxf(kq[bj], q_); } } }
            LOADS_DONE();
        }
        if (KMAX) { if (wc < 2) {
#pragma unroll
            for (int bj = 0; bj < 2; ++bj) { float q_ = kq[bj];
                { q_ = fmaxf(q_, sx<1>(q_)); q_ = fmaxf(q_, sx<2>(q_)); q_ = fmaxf(q_, sx<4>(q_)); q_ = fmaxf(q_, sx<8>(q_)); }
                if ((fr | fq) == 0) (void)__hip_atomic_fetch_max((GAS unsigned*)kmx + ((u.pm * 256 / SEQ) * NH + u.pn * 2 + bj) * 2 + wc, __float_as_uint(q_), __ATOMIC_RELAXED, __HIP_MEMORY_SCOPE_AGENT); } } }
    }
};
template <bool GATED> struct EpiRes {
    static constexpr int NST = 16;
    const bf16_t* xbin; bf16_t* xo16; unsigned char* xo8; float* rspn; const float* rs; const bf16_t* pp;
    __device__ __forceinline__ void operator()(const Acc& acc, const Unit& u, int wr, int wc, int fr, int fq) const {
        constexpr int MB = GATED ? 2 : 4;
#pragma unroll
        for (int ai = 0; ai < 2; ++ai)
#pragma unroll
        for (int m0 = 0; m0 < 4; m0 += MB) {
            u32x4 bb[MB][2], pv[MB][2]; float rv[MB];
#pragma unroll
            for (int mi = 0; mi < MB; ++mi) { const int row = EPI_ROW(u, ai, m0 + mi);
                if (GATED) rv[mi] = rs[row];
#pragma unroll
                for (int bj = 0; bj < 2; ++bj) { const size_t o = (size_t)row * DM + u.pn * 256 + EPI_COL(bj);
                    bb[mi][bj] = *(const u32x4*)(xbin + o);
                    if (GATED) pv[mi][bj] = *(const u32x4*)(pp + o); } }
            LOADS_DONE();
#pragma unroll
            for (int mi = 0; mi < MB; ++mi) { const int m = m0 + mi; const int row = EPI_ROW(u, ai, m);
                float sc = 1.0f; if (GATED) sc = __builtin_amdgcn_rsqf(rv[mi] * (1.0f / DM) + EPS);
                float ss = 0.f;
#pragma unroll
                for (int bj = 0; bj < 2; ++bj) { const size_t o = (size_t)row * DM + u.pn * 256 + EPI_COL(bj);
                    f32x4 v0 = acc[ai][bj][m][0], v1 = acc[ai][bj][m][1];
                    if (GATED) { f32x4 p0, p1; unpack8(pv[mi][bj], p0, p1);
#pragma unroll
                        for (int i = 0; i < 4; ++i) { v0[i] = fsigmoid(v0[i] * sc) * p0[i]; v1[i] = fsigmoid(v1[i] * sc) * p1[i]; } }
                    { f32x4 b0, b1; unpack8(bb[mi][bj], b0, b1); v0 = v0 + b0; v1 = v1 + b1; }
                    *(u32x4*)(xo16 + o) = pack8(v0, v1);
                    if (xo8) { u32x2 w8; w8.x = pk4_fp8(4.f * v0[0], 4.f * v0[1], 4.f * v0[2], 4.f * v0[3]); w8.y = pk4_fp8(4.f * v1[0], 4.f * v1[1], 4.f * v1[2], 4.f * v1[3]); *(u32x2*)(xo8 + o) = w8; }
                    ss += (v0[0] * v0[0] + v0[1] * v0[1]) + (v0[2] * v0[2] + v0[3] * v0[3]) + (v1[0] * v1[0] + v1[1] * v1[1]) + (v1[2] * v1[2] + v1[3] * v1[3]); }
                ss += sx<16>(ss); ss = sum32(ss);
                if (fq == 0) rspn[(size_t)row * 16 + u.pn * 4 + wc] = ss; }
            LOADS_DONE();
        }
    }
};
struct EpiSwiglu {
    static constexpr int NST = 8;
    unsigned char* hm; const float* bg; const float* bu;
    __device__ __forceinline__ void operator()(const Acc& acc, const Unit& u, int wr, int wc, int fr, int fq) const {
        const int hc = u.pn * 128 + wc * 32 + 8 * fq;
        const f32x4 bg0 = *(const f32x4*)(bg + u.aux * DE + hc), bg1 = *(const f32x4*)(bg + u.aux * DE + hc + 4);
        const f32x4 bu0 = *(const f32x4*)(bu + u.aux * DE + hc), bu1 = *(const f32x4*)(bu + u.aux * DE + hc + 4);
        LOADS_DONE();
#pragma unroll
        for (int ai = 0; ai < 2; ++ai)
#pragma unroll
            for (int m = 0; m < 4; ++m) {
                const int row = EPI_ROW(u, ai, m);
                f32x4 g0 = acc[ai][0][m][0] + bg0, g1 = acc[ai][0][m][1] + bg1, u0 = acc[ai][1][m][0] + bu0, u1 = acc[ai][1][m][1] + bu1;
#pragma unroll
                for (int i = 0; i < 4; ++i) { g0[i] = fminf(g0[i], 7.0f); g1[i] = fminf(g1[i], 7.0f); }
                f32x4 e0 = g0 * (-1.702f * LOG2E), e1 = g1 * (-1.702f * LOG2E);
#pragma unroll
                for (int i = 0; i < 4; ++i) { e0[i] = __builtin_amdgcn_exp2f(e0[i]); e1[i] = __builtin_amdgcn_exp2f(e1[i]); }
                e0 = e0 + 1.0f; e1 = e1 + 1.0f;
#pragma unroll
                for (int i = 0; i < 4; ++i) { e0[i] = __builtin_amdgcn_rcpf(e0[i]); e1[i] = __builtin_amdgcn_rcpf(e1[i]); u0[i] = __builtin_amdgcn_fmed3f(u0[i], -7.0f, 7.0f); u1[i] = __builtin_amdgcn_fmed3f(u1[i], -7.0f, 7.0f); }
                g0 = (g0 * e0) * (u0 * 4.0f + 4.0f); g1 = (g1 * e1) * (u1 * 4.0f + 4.0f);
                u32x2 w; w.x = pk4_fp8_nc(g0[0], g0[1], g0[2], g0[3]); w.y = pk4_fp8_nc(g1[0], g1[1], g1[2], g1[3]);
                *(u32x2*)(hm + (size_t)row * DE + hc) = w;
            }
    }
};
struct EpiDown {
    static constexpr int NST = 16;
    unsigned char* y; const float* wl; const float* bd;
    __device__ __forceinline__ void operator()(const Acc& acc, const Unit& u, int wr, int wc, int fr, int fq) const {
        f32x4 b0[2], b1[2]; float w[2][4];
#pragma unroll
        for (int bj = 0; bj < 2; ++bj) { const int col = u.pn * 256 + EPI_COL(bj); b0[bj] = *(const f32x4*)(bd + u.aux * DM + col); b1[bj] = *(const f32x4*)(bd + u.aux * DM + col + 4); }
#pragma unroll
        for (int ai = 0; ai < 2; ++ai)
#pragma unroll
            for (int m = 0; m < 4; ++m) w[ai][m] = 8.0f * wl[(size_t)u.aux * 32768 + u.rl * 256 + ai * 128 + wr * 64 + m * 16 + fr];
        LOADS_DONE();
#pragma unroll
        for (int ai = 0; ai < 2; ++ai)
#pragma unroll
            for (int m = 0; m < 4; ++m) {
                const int row = EPI_ROW(u, ai, m);
#pragma unroll
                for (int bj = 0; bj < 2; ++bj) {
                    const int col = u.pn * 256 + EPI_COL(bj);
                    const f32x4 y0 = (acc[ai][bj][m][0] + b0[bj]) * w[ai][m], y1 = (acc[ai][bj][m][1] + b1[bj]) * w[ai][m];
                    u32x2 w8; w8.x = pk4_fp8(y0[0], y0[1], y0[2], y0[3]); w8.y = pk4_fp8(y1[0], y1[1], y1[2], y1[3]); *(u32x2*)(y + (size_t)row * DM + col) = w8;
                }
            }
    }
};
}

namespace att {
constexpr int KVBLK = 64;
constexpr int SHM_K = 64 * 256, SHM_V = 64 * 64 * 2;
constexpr int OFF_K = 0, OFF_V = 2 * SHM_K, OFF_WS = 2 * SHM_K + 2 * SHM_V, ATT_LDS = OFF_WS + 8 * 256;
constexpr float THR = 8.0f;
#define KSWZ(row, colB) ((row) * 256 + ((colB) ^ (((row) & 7) << 4)))
#define SBAR() __builtin_amdgcn_sched_barrier(0)
__device__ __forceinline__ int v_st(int k, int c) { const int kk = k; return ((kk >> 3) * 2 + (c >> 5)) * 512 + ((kk & 7) * 32 + (c & 31)) * 2; }
__device__ __forceinline__ int v_rd_base(int lane) { return ((lane & 3) << 3) | (((lane >> 2) & 3) << 6) | (((lane >> 4) & 1) << 5) | (((lane >> 5) & 1) << 8); }
constexpr int v_rd_off(int d0, int ks, int half) { return d0 * 512 + ks * 2048 + half * 1024; }
template <int OFF> __device__ __forceinline__ s16x4 tr_read(int vb) { s16x4 r; asm volatile("ds_read_b64_tr_b16 %0, %1 offset:%2" : "=&v"(r) : "v"(vb), "i"(OFF) : "memory"); return r; }
template <int D0> __device__ __forceinline__ void pv_one(f32x16& od, int vb, bf16x8 pa0, bf16x8 pa1, bf16x8 pa2, bf16x8 pa3) {
    const s16x4 l0 = tr_read<v_rd_off(D0, 0, 0)>(vb), h0 = tr_read<v_rd_off(D0, 0, 1)>(vb), l1 = tr_read<v_rd_off(D0, 1, 0)>(vb), h1 = tr_read<v_rd_off(D0, 1, 1)>(vb);
    const s16x4 l2 = tr_read<v_rd_off(D0, 2, 0)>(vb), h2 = tr_read<v_rd_off(D0, 2, 1)>(vb), l3 = tr_read<v_rd_off(D0, 3, 0)>(vb), h3 = tr_read<v_rd_off(D0, 3, 1)>(vb);
    asm volatile("s_waitcnt lgkmcnt(0)" ::: "memory"); SBAR();
#define PK(L, H) (bf16x8){L[0], L[1], L[2], L[3], H[0], H[1], H[2], H[3]}
    od = __builtin_amdgcn_mfma_f32_32x32x16_bf16(pa0, PK(l0, h0), od, 0, 0, 0);
    od = __builtin_amdgcn_mfma_f32_32x32x16_bf16(pa1, PK(l1, h1), od, 0, 0, 0);
    od = __builtin_amdgcn_mfma_f32_32x32x16_bf16(pa2, PK(l2, h2), od, 0, 0, 0);
    od = __builtin_amdgcn_mfma_f32_32x32x16_bf16(pa3, PK(l3, h3), od, 0, 0, 0);
#undef PK
}
__device__ __forceinline__ void pv_d0(f32x16* o, int vb, bf16x8 pa0, bf16x8 pa1, bf16x8 pa2, bf16x8 pa3) { pv_one<0>(o[0], vb, pa0, pa1, pa2, pa3); pv_one<1>(o[1], vb, pa0, pa1, pa2, pa3); }
__device__ __forceinline__ void partialSM(f32x16& p0, f32x16& p1, float& m_reg, float& alpha) {
    float pmax = p0[0];
#pragma unroll
    for (int r = 1; r < 16; ++r) pmax = fmaxf(pmax, p0[r]);
#pragma unroll
    for (int r = 0; r < 16; ++r) pmax = fmaxf(pmax, p1[r]);
    { auto rr = __builtin_amdgcn_permlane32_swap(__float_as_uint(pmax), __float_as_uint(pmax), false, false); pmax = fmaxf(__uint_as_float(rr[0]), __uint_as_float(rr[1])); }
    float mn;
    if (__builtin_expect(__all(pmax - m_reg <= THR), 1)) { mn = m_reg; alpha = 1.f; }
    else { mn = fmaxf(m_reg, pmax); alpha = __builtin_amdgcn_exp2f(m_reg - mn); m_reg = mn; }
#pragma unroll
    for (int r = 0; r < 16; ++r) { p0[r] = p0[r] - mn; p1[r] = p1[r] - mn; }
#pragma unroll
    for (int r = 0; r < 16; ++r) p0[r] = __builtin_amdgcn_exp2f(p0[r]);
}
__device__ __forceinline__ void finishSM(f32x16& p0, f32x16& p1, float alpha, float& l_reg, bf16x8& pa0, bf16x8& pa1, bf16x8& pa2, bf16x8& pa3) {
#pragma unroll
    for (int r = 0; r < 16; ++r) p1[r] = __builtin_amdgcn_exp2f(p1[r]);
    float ps = 0;
#pragma unroll
    for (int r = 0; r < 16; ++r) ps += p0[r];
#pragma unroll
    for (int r = 0; r < 16; ++r) ps += p1[r];
    { auto rr = __builtin_amdgcn_permlane32_swap(__float_as_uint(ps), __float_as_uint(ps), false, false); ps = __uint_as_float(rr[0]) + __uint_as_float(rr[1]); }
    l_reg = l_reg * alpha + ps;
#define PK4(P, BASE, OUT) do { unsigned a0 = cvtpk(P[BASE + 0], P[BASE + 1]), a1 = cvtpk(P[BASE + 2], P[BASE + 3]);   \
    unsigned b0 = cvtpk(P[BASE + 4], P[BASE + 5]), b1 = cvtpk(P[BASE + 6], P[BASE + 7]);                              \
    auto r0 = __builtin_amdgcn_permlane32_swap(a0, b0, false, false); auto r1 = __builtin_amdgcn_permlane32_swap(a1, b1, false, false); \
    u32x4 w = {r0[0], r1[0], r0[1], r1[1]}; OUT = __builtin_bit_cast(bf16x8, w); } while (0)
    PK4(p0, 0, pa0); PK4(p0, 8, pa1); PK4(p1, 0, pa2); PK4(p1, 8, pa3);
#undef PK4
}
template <int NQ> __device__ __forceinline__ void qkt_c(f32x16& p0, f32x16& p1, const LAS char* Ks, const bf16x8* qr, int r32, int hi, const f32x16& c0) {
    p0 = c0; p1 = c0;
#pragma unroll
    for (int d0 = 0; d0 < NQ; ++d0) { const int cb = (d0 * 16 + hi * 8) * 2;
        const bf16x8 b0 = *(const LAS bf16x8*)(Ks + KSWZ(r32, cb));
        const bf16x8 b1 = *(const LAS bf16x8*)(Ks + KSWZ(32 + r32, cb));
        p0 = __builtin_amdgcn_mfma_f32_32x32x16_bf16(b0, qr[d0], p0, 0, 0, 0);
        p1 = __builtin_amdgcn_mfma_f32_32x32x16_bf16(b1, qr[d0], p1, 0, 0, 0); }
}
template <int NQ> __device__ __forceinline__ void qkt_c128(f32x16& p0, f32x16& p1, const LAS char* Ks, const bf16x8* qr, int r32, int hi, const f32x16& c0) {
    p0 = c0; p1 = c0;
#pragma unroll
    for (int d0 = 0; d0 < NQ; ++d0) { const int cb = ((d0 * 2 + hi) ^ (r32 & 7)) << 4;
        const bf16x8 b0 = *(const LAS bf16x8*)(Ks + r32 * 128 + cb);
        const bf16x8 b1 = *(const LAS bf16x8*)(Ks + (32 + r32) * 128 + cb);
        p0 = __builtin_amdgcn_mfma_f32_32x32x16_bf16(b0, qr[d0], p0, 0, 0, 0);
        p1 = __builtin_amdgcn_mfma_f32_32x32x16_bf16(b1, qr[d0], p1, 0, 0, 0); }
}
template <int NQ> __device__ __forceinline__ void qkt(f32x16& p0, f32x16& p1, const LAS char* Ks, const bf16x8* qr, int r32, int hi) {
    p0 = f32x16{}; p1 = f32x16{};
#pragma unroll
    for (int d0 = 0; d0 < NQ; ++d0) { const int cb = (d0 * 16 + hi * 8) * 2;
        const bf16x8 b0 = *(const LAS bf16x8*)(Ks + KSWZ(r32, cb));
        const bf16x8 b1 = *(const LAS bf16x8*)(Ks + KSWZ(32 + r32, cb));
        p0 = __builtin_amdgcn_mfma_f32_32x32x16_bf16(b0, qr[d0], p0, 0, 0, 0);
        p1 = __builtin_amdgcn_mfma_f32_32x32x16_bf16(b1, qr[d0], p1, 0, 0, 0); }
}
__device__ __forceinline__ void partialSM_nb(f32x16& p0, f32x16& p1, float& m_reg, float& alpha) {
    float pmax = p0[0];
#pragma unroll
    for (int r = 1; r < 16; ++r) pmax = fmaxf(pmax, p0[r]);
#pragma unroll
    for (int r = 0; r < 16; ++r) pmax = fmaxf(pmax, p1[r]);
    { auto rr = __builtin_amdgcn_permlane32_swap(__float_as_uint(pmax), __float_as_uint(pmax), false, false); pmax = fmaxf(__uint_as_float(rr[0]), __uint_as_float(rr[1])); }
    const bool keep = __all(pmax - m_reg <= THR);
    const float mn = keep ? m_reg : fmaxf(m_reg, pmax);
    alpha = __builtin_amdgcn_exp2f(m_reg - mn);
    m_reg = mn;
#pragma unroll
    for (int r = 0; r < 16; ++r) { p0[r] = p0[r] - mn; p1[r] = p1[r] - mn; }
#pragma unroll
    for (int r = 0; r < 16; ++r) p0[r] = __builtin_amdgcn_exp2f(p0[r]);
}
__device__ __forceinline__ void pv_all(f32x16* o, int vb, bf16x8 pa0, bf16x8 pa1, bf16x8 pa2, bf16x8 pa3, s16x4 (&l)[8], s16x4 (&h)[8]) {
#define PK(L, H) (bf16x8){L[0], L[1], L[2], L[3], H[0], H[1], H[2], H[3]}
    o[0] = __builtin_amdgcn_mfma_f32_32x32x16_bf16(pa0, PK(l[0], h[0]), o[0], 0, 0, 0); o[1] = __builtin_amdgcn_mfma_f32_32x32x16_bf16(pa0, PK(l[4], h[4]), o[1], 0, 0, 0);
    o[0] = __builtin_amdgcn_mfma_f32_32x32x16_bf16(pa1, PK(l[1], h[1]), o[0], 0, 0, 0); o[1] = __builtin_amdgcn_mfma_f32_32x32x16_bf16(pa1, PK(l[5], h[5]), o[1], 0, 0, 0);
    o[0] = __builtin_amdgcn_mfma_f32_32x32x16_bf16(pa2, PK(l[2], h[2]), o[0], 0, 0, 0); o[1] = __builtin_amdgcn_mfma_f32_32x32x16_bf16(pa2, PK(l[6], h[6]), o[1], 0, 0, 0);
    o[0] = __builtin_amdgcn_mfma_f32_32x32x16_bf16(pa3, PK(l[3], h[3]), o[0], 0, 0, 0); o[1] = __builtin_amdgcn_mfma_f32_32x32x16_bf16(pa3, PK(l[7], h[7]), o[1], 0, 0, 0);
#undef PK
}
__device__ __forceinline__ void pv_reads(int vb, s16x4 (&l)[8], s16x4 (&h)[8]) {
    l[0] = tr_read<v_rd_off(0, 0, 0)>(vb); h[0] = tr_read<v_rd_off(0, 0, 1)>(vb); l[1] = tr_read<v_rd_off(0, 1, 0)>(vb); h[1] = tr_read<v_rd_off(0, 1, 1)>(vb);
    l[2] = tr_read<v_rd_off(0, 2, 0)>(vb); h[2] = tr_read<v_rd_off(0, 2, 1)>(vb); l[3] = tr_read<v_rd_off(0, 3, 0)>(vb); h[3] = tr_read<v_rd_off(0, 3, 1)>(vb);
    l[4] = tr_read<v_rd_off(1, 0, 0)>(vb); h[4] = tr_read<v_rd_off(1, 0, 1)>(vb); l[5] = tr_read<v_rd_off(1, 1, 0)>(vb); h[5] = tr_read<v_rd_off(1, 1, 1)>(vb);
    l[6] = tr_read<v_rd_off(1, 2, 0)>(vb); h[6] = tr_read<v_rd_off(1, 2, 1)>(vb); l[7] = tr_read<v_rd_off(1, 3, 0)>(vb); h[7] = tr_read<v_rd_off(1, 3, 1)>(vb);
    asm volatile("s_waitcnt lgkmcnt(0)" ::: "memory"); SBAR();
}
struct Args {
    const bf16_t* Q; long ldq;
    const bf16_t* K; long ldk;
    const bf16_t* K2; long ldk2;
    const bf16_t* V; long ldv;
    bf16_t* O; long ldo; float* lse; long ldlse;
    const float* cosT; const float* sinT;
    int t0, t1;
    int qoff;
    int tmask;
    float ab;
    float kn;
};
template <int MODE> __device__ __forceinline__ void mask_tile(f32x16& p0, f32x16& p1, int t, int n, int hi, const Args& a) {
    const int base = n + a.qoff - 64 * t - 4 * hi;
    if (MODE == 0) {
#pragma unroll
        for (int r = 0; r < 16; ++r) { const int rel = base - ((r & 3) + 8 * (r >> 2)); if (rel < 0) p0[r] = -INFINITY; if (rel - 32 < 0) p1[r] = -INFINITY; }
    } else {
#pragma unroll
        for (int r = 0; r < 16; ++r) { const int rel = base - ((r & 3) + 8 * (r >> 2)); const int rel1 = rel - 32;
            p0[r] = (rel < 0 || rel > 128) ? -INFINITY : p0[r] - a.ab * (float)rel;
            p1[r] = (rel1 < 0 || rel1 > 128) ? -INFINITY : p1[r] - a.ab * (float)rel1; }
    }
}
template <int MODE> __device__ __forceinline__ void attn_unit(const Args& a, LAS char* lds, int wave_in) {
    constexpr int NQ = MODE == 0 ? 6 : 4;
    int wid = wave_in; asm volatile("" : "+s"(wid)); int lane = (int)__builtin_amdgcn_mbcnt_hi(~0u, __builtin_amdgcn_mbcnt_lo(~0u, 0u)); asm volatile("" : "+v"(lane)); const int tid = wid * 64 + lane;
    const int r32 = lane & 31, hi = lane >> 5;
    LAS char* V_lds = lds + OFF_V; LAS char* K_lds = lds + OFF_K;
    LAS float* ws = (LAS float*)(lds + (MODE == 0 ? 3 * SHM_K + 3 * SHM_V : 12 * 8192)) + wid * 64; LAS float* li_l = ws; LAS float* al_l = ws + 32; (void)al_l;
    float m_reg = -1e30f, l_reg = 0; f32x16 o[2] = {}; bf16x8 qr[NQ];
    const bf16_t* Qw = a.Q + (long)(wid * 32 + r32) * a.ldq + hi * 8;
#pragma unroll
    for (int d0 = 0; d0 < NQ; ++d0) qr[d0] = *(const bf16x8*)(Qw + d0 * 16);
    if (MODE == 0) {
        const int pos = a.qoff + wid * 32 + r32;
#pragma unroll
        for (int d0 = 4; d0 < 6; ++d0) { const int jg = 2 * (d0 - 4) + hi;
            const f32x4 cs = *(const f32x4*)(a.cosT + pos * 16 + 4 * jg), sn = *(const f32x4*)(a.sinT + pos * 16 + 4 * jg);
            f32x4 v0, v1; unpack8(__builtin_bit_cast(u32x4, qr[d0 < NQ ? d0 : 0]), v0, v1);
            const f32x4 o0 = v0 * cs - v1 * sn, o1 = v0 * sn + v1 * cs;
            if (d0 < NQ) qr[d0] = __builtin_bit_cast(bf16x8, pack8(o0, o1)); }
    }
    const int sr = tid >> 4, kc = tid & 15, vr = tid >> 3, vc = tid & 7;
    const int vst = v_st(vr, vc * 8);
    const int vb0 = (int)(uintptr_t)V_lds + v_rd_base(lane);
    const bf16_t* kp0; const bf16_t* kp1; long kstep64; int kst0, kst1;
    if (MODE == 0) { const bool rope = kc >= 8; const int kcc = rope ? ((kc - 8) & 3) : kc;
        kp0 = rope ? a.K2 + (long)sr * a.ldk2 + kcc * 8 : a.K + (long)sr * a.ldk + kcc * 8;
        kp1 = rope ? a.K2 + (long)(sr + 32) * a.ldk2 + kcc * 8 : a.K + (long)(sr + 32) * a.ldk + kcc * 8;
        kstep64 = rope ? 64 * a.ldk2 : 64 * a.ldk; kst0 = KSWZ(sr, kc * 16); kst1 = KSWZ(sr + 32, kc * 16);
    } else { kp0 = a.K + (long)vr * a.ldk + vc * 8; kp1 = kp0; kstep64 = 64 * a.ldk; kst0 = KSWZ(vr, vc * 16); kst1 = kst0; }
    const bf16_t* vp = a.V + (long)vr * a.ldv + vc * 8; const long vstep64 = 64 * a.ldv;
    struct Slot { bf16x8 v, k0, k1; } sl[1];
#define SLOAD(i, t) do { sl[i].v = *(const bf16x8*)(vp + (long)(t) * vstep64); sl[i].k0 = *(const bf16x8*)(kp0 + (long)(t) * kstep64); \
        if (MODE == 0) sl[i].k1 = *(const bf16x8*)(kp1 + (long)(t) * kstep64); } while (0)
#define SWRITE(b, i) do { *(LAS bf16x8*)(V_lds + (b) * SHM_V + vst) = sl[i].v; *(LAS bf16x8*)(K_lds + (b) * SHM_K + kst0) = sl[i].k0; \
        if (MODE == 0) *(LAS bf16x8*)(K_lds + (b) * SHM_K + kst1) = sl[i].k1; } while (0)
#define SWAIT() asm volatile("s_waitcnt vmcnt(0)" ::: "memory")
#define RESC(al) do { if (__any((al) < 1.f)) { if (hi == 0) al_l[r32] = (al); asm volatile("s_waitcnt lgkmcnt(0)" ::: "memory"); \
        _Pragma("unroll") for (int d = 0; d < 2; ++d) _Pragma("unroll") for (int r = 0; r < 16; ++r) o[d][r] *= al_l[crow(r, hi)]; } } while (0)
    f32x16 pA0, pA1, pB0, pB1; float alA = 1.f, alB = 1.f; bf16x8 pa0, pa1, pa2, pa3;
    const int N = a.t1 - a.t0, T0 = a.t0, n = wid * 32 + r32;
#define NEED(t) (MODE == 0 ? true : (32 * wid + 159 - 64 * (t) >= 0 && 32 * wid + 65 - 64 * (t) <= 128))
    if constexpr (MODE == 0) {
        float qs = 0.f;
#pragma unroll
        for (int d0 = 0; d0 < NQ; ++d0) { f32x4 v0, v1; unpack8(__builtin_bit_cast(u32x4, qr[d0]), v0, v1); qs += (v0[0] * v0[0] + v0[1] * v0[1]) + (v0[2] * v0[2] + v0[3] * v0[3]) + (v1[0] * v1[0] + v1[1] * v1[1]) + (v1[2] * v1[2] + v1[3] * v1[3]); }
        qs = sum32(qs);
        const float nb_ = -sqrtf(qs) * a.kn;
        f32x16 negm;
#pragma unroll
        for (int r = 0; r < 16; ++r) negm[r] = nb_;
#define SGB_QK() do { _Pragma("unroll") for (int _g = 0; _g < 12; ++_g) { __builtin_amdgcn_sched_group_barrier(0x008, 1, 0); __builtin_amdgcn_sched_group_barrier(0x100, 2, 0); \
        __builtin_amdgcn_sched_group_barrier(0x002, 6, 0); } } while (0)
#define SGB_PV() do { _Pragma("unroll") for (int _g = 0; _g < 8; ++_g) { __builtin_amdgcn_sched_group_barrier(0x008, 1, 0); __builtin_amdgcn_sched_group_barrier(0x400, 4, 0); } } while (0)
#define PVEXP(vb_, P0, P1) do { \
        { const s16x4 l0 = tr_read<v_rd_off(0, 0, 0)>(vb_), h0 = tr_read<v_rd_off(0, 0, 1)>(vb_), l1 = tr_read<v_rd_off(0, 1, 0)>(vb_), h1 = tr_read<v_rd_off(0, 1, 1)>(vb_); \
          const s16x4 l2 = tr_read<v_rd_off(0, 2, 0)>(vb_), h2 = tr_read<v_rd_off(0, 2, 1)>(vb_), l3 = tr_read<v_rd_off(0, 3, 0)>(vb_), h3 = tr_read<v_rd_off(0, 3, 1)>(vb_); \
          asm volatile("s_waitcnt lgkmcnt(0)" ::: "memory"); SBAR(); \
          o[0] = __builtin_amdgcn_mfma_f32_32x32x16_bf16(pa0, PKV(l0, h0), o[0], 0, 0, 0); o[0] = __builtin_amdgcn_mfma_f32_32x32x16_bf16(pa1, PKV(l1, h1), o[0], 0, 0, 0); \
          o[0] = __builtin_amdgcn_mfma_f32_32x32x16_bf16(pa2, PKV(l2, h2), o[0], 0, 0, 0); o[0] = __builtin_amdgcn_mfma_f32_32x32x16_bf16(pa3, PKV(l3, h3), o[0], 0, 0, 0); \
          _Pragma("unroll") for (int r = 0; r < 16; ++r) P0[r] = __builtin_amdgcn_exp2f(P0[r]); \
          _Pragma("unroll") for (int _g = 0; _g < 4; ++_g) { __builtin_amdgcn_sched_group_barrier(0x008, 1, 0); __builtin_amdgcn_sched_group_barrier(0x400, 4, 0); } SBAR(); } \
        { const s16x4 l0 = tr_read<v_rd_off(1, 0, 0)>(vb_), h0 = tr_read<v_rd_off(1, 0, 1)>(vb_), l1 = tr_read<v_rd_off(1, 1, 0)>(vb_), h1 = tr_read<v_rd_off(1, 1, 1)>(vb_); \
          const s16x4 l2 = tr_read<v_rd_off(1, 2, 0)>(vb_), h2 = tr_read<v_rd_off(1, 2, 1)>(vb_), l3 = tr_read<v_rd_off(1, 3, 0)>(vb_), h3 = tr_read<v_rd_off(1, 3, 1)>(vb_); \
          asm volatile("s_waitcnt lgkmcnt(0)" ::: "memory"); SBAR(); \
          o[1] = __builtin_amdgcn_mfma_f32_32x32x16_bf16(pa0, PKV(l0, h0), o[1], 0, 0, 0); o[1] = __builtin_amdgcn_mfma_f32_32x32x16_bf16(pa1, PKV(l1, h1), o[1], 0, 0, 0); \
          o[1] = __builtin_amdgcn_mfma_f32_32x32x16_bf16(pa2, PKV(l2, h2), o[1], 0, 0, 0); o[1] = __builtin_amdgcn_mfma_f32_32x32x16_bf16(pa3, PKV(l3, h3), o[1], 0, 0, 0); \
          _Pragma("unroll") for (int r = 0; r < 16; ++r) P1[r] = __builtin_amdgcn_exp2f(P1[r]); \
          _Pragma("unroll") for (int _g = 0; _g < 4; ++_g) { __builtin_amdgcn_sched_group_barrier(0x008, 1, 0); __builtin_amdgcn_sched_group_barrier(0x400, 4, 0); } SBAR(); } } while (0)
#define PKV(L, H) (bf16x8){L[0], L[1], L[2], L[3], H[0], H[1], H[2], H[3]}
#define EXP32(P0, P1) do { _Pragma("unroll") for (int r = 0; r < 16; ++r) { P0[r] = __builtin_amdgcn_exp2f(P0[r]); P1[r] = __builtin_amdgcn_exp2f(P1[r]); } } while (0)
#define PACKSUM(P0, P1) do { float s_ = 0.f; _Pragma("unroll") for (int r = 0; r < 16; ++r) s_ += P0[r] + P1[r]; l_reg += s_; \
        PK4_(P0, 0, pa0); PK4_(P0, 8, pa1); PK4_(P1, 0, pa2); PK4_(P1, 8, pa3); } while (0)
#define PK4_(P, BASE, OUT) do { u32x4 w = {cvtpk(P[BASE + 0], P[BASE + 1]), cvtpk(P[BASE + 2], P[BASE + 3]), cvtpk(P[BASE + 4], P[BASE + 5]), cvtpk(P[BASE + 6], P[BASE + 7])}; \
        OUT = __builtin_bit_cast(bf16x8, w); } while (0)
        LAS char* const V0 = lds + 3 * SHM_K;
        const int vbase = (int)(uintptr_t)V0 + v_rd_base(lane);
        unsigned koff[2]; bool krope[2];
#pragma unroll
        for (int i = 0; i < 2; ++i) { const int row = 8 * wid + 4 * i + (lane >> 4), c = (lane & 15) ^ (row & 7); krope[i] = c >= 8;
            koff[i] = krope[i] ? (unsigned)(row * a.ldk2 + ((c - 8) & 3) * 8) * 2u : (unsigned)(row * a.ldk + c * 8) * 2u; }
        const int kk_ = 8 * wid + ((lane & 31) >> 2); const int vkey = kk_;
        const unsigned voff = (unsigned)(vkey * a.ldv + 32 * (lane >> 5) + 8 * (lane & 3)) * 2u;
        const unsigned ldsK = (unsigned)(uintptr_t)lds + (unsigned)wid * 2048u, ldsV = (unsigned)(uintptr_t)V0 + (unsigned)wid * 1024u;
#define DMA_TILE(t_, slot_) do { const char* kb_ = (const char*)a.K + (size_t)(t_) * 128 * a.ldk; const char* k2_ = (const char*)a.K2 + (size_t)(t_) * 128 * a.ldk2; const char* vb_ = (const char*)a.V + (size_t)(t_) * 128 * a.ldv; \
        _Pragma("unroll") for (int i_ = 0; i_ < 2; ++i_) { const char* src_ = (krope[i_] ? k2_ : kb_) + koff[i_]; const unsigned la_ = ldsK + (unsigned)(slot_) * SHM_K + i_ * 1024u; \
            asm volatile("s_mov_b32 m0, %1\n\ts_nop 0\n\tglobal_load_lds_dwordx4 %0, off" :: "v"(src_), "s"(la_) : "memory", "m0"); } \
        { const unsigned la_ = ldsV + (unsigned)(slot_) * SHM_V; asm volatile("s_mov_b32 m0, %2\n\ts_nop 0\n\tglobal_load_lds_dwordx4 %0, %1" :: "v"(voff), "s"(vb_), "s"(la_) : "memory", "m0"); } } while (0)
#define STEP_END() do { asm volatile("s_waitcnt vmcnt(0)" ::: "memory"); __syncthreads(); } while (0)
        DMA_TILE(T0, 0); STEP_END();
        DMA_TILE(T0 + 1, 1);
        qkt_c<NQ>(pA0, pA1, K_lds, qr, r32, hi, negm); if (T0 >= a.tmask) mask_tile<MODE>(pA0, pA1, T0, n, hi, a); EXP32(pA0, pA1);
        STEP_END();
        int sc_ = 1, sp_ = 0, sn_ = 2;
#define STEP0(t_, PX0, PX1, PY0, PY1, MK) do { \
        if ((t_) + 1 < N) DMA_TILE(T0 + (t_) + 1, sn_); \
        SBAR(); qkt_c<NQ>(PX0, PX1, K_lds + sc_ * SHM_K, qr, r32, hi, negm); if (MK) mask_tile<MODE>(PX0, PX1, T0 + (t_), n, hi, a); \
        PACKSUM(PY0, PY1); SGB_QK(); SBAR(); \
        PVEXP(vbase + sp_ * SHM_V, PX0, PX1); \
        STEP_END(); { const int o_ = sp_; sp_ = sc_; sc_ = sn_; sn_ = o_; } } while (0)
        int t = 1;
        for (; t + 5 < N; t += 2) { STEP0(t, pB0, pB1, pA0, pA1, false); STEP0(t + 1, pA0, pA1, pB0, pB1, false); }
        for (; t + 1 < N; t += 2) { STEP0(t, pB0, pB1, pA0, pA1, true); STEP0(t + 1, pA0, pA1, pB0, pB1, true); }
        STEP0(N - 1, pB0, pB1, pA0, pA1, true);
#undef STEP0
#undef DMA_TILE
#undef STEP_END
        PACKSUM(pB0, pB1); SBAR();
        pv_d0(o, vbase + sp_ * SHM_V, pa0, pa1, pa2, pa3);
        l_reg = sum32(l_reg);
#undef SGB_QK
#undef SGB_PV
#undef EXP32
#undef PVEXP
#undef PKV
#undef PACKSUM
#undef PK4_
    } else {
    float qs = 0.f;
#pragma unroll
    for (int d0 = 0; d0 < NQ; ++d0) { f32x4 v0, v1; unpack8(__builtin_bit_cast(u32x4, qr[d0]), v0, v1); qs += (v0[0] * v0[0] + v0[1] * v0[1]) + (v0[2] * v0[2] + v0[3] * v0[3]) + (v1[0] * v1[0] + v1[1] * v1[1]) + (v1[2] * v1[2] + v1[3] * v1[3]); }
    qs = sum32(qs);
    const float nb_ = -sqrtf(qs) * a.kn; m_reg = -nb_;
    f32x16 negm;
#pragma unroll
    for (int r = 0; r < 16; ++r) negm[r] = nb_;
#define EXP32(P0, P1) do { _Pragma("unroll") for (int r = 0; r < 16; ++r) { P0[r] = __builtin_amdgcn_exp2f(P0[r]); P1[r] = __builtin_amdgcn_exp2f(P1[r]); } } while (0)
#define PK4_(P, BASE, OUT) do { u32x4 w = {cvtpk(P[BASE + 0], P[BASE + 1]), cvtpk(P[BASE + 2], P[BASE + 3]), cvtpk(P[BASE + 4], P[BASE + 5]), cvtpk(P[BASE + 6], P[BASE + 7])}; \
        OUT = __builtin_bit_cast(bf16x8, w); } while (0)
#define PACKSUM(P0, P1) do { float s_ = 0.f; _Pragma("unroll") for (int r = 0; r < 16; ++r) s_ += P0[r] + P1[r]; l_reg += s_; \
        PK4_(P0, 0, pa0); PK4_(P0, 8, pa1); PK4_(P1, 0, pa2); PK4_(P1, 8, pa3); } while (0)
    LAS char* const KD = lds; LAS char* const VD = lds + 6 * 8192;
    const int vbase = (int)(uintptr_t)VD + v_rd_base(lane);
    { const int row = 8 * wid + (lane >> 3), c = (lane & 7) ^ (row & 7);
      const unsigned koff = (unsigned)(row * a.ldk + c * 8) * 2u;
      const int kk_ = 8 * wid + ((lane & 31) >> 2); const unsigned voff = (unsigned)(kk_ * a.ldv + 32 * (lane >> 5) + 8 * (lane & 3)) * 2u;
      const unsigned ldsK = (unsigned)(uintptr_t)KD + (unsigned)wid * 1024u, ldsV = (unsigned)(uintptr_t)VD + (unsigned)wid * 1024u;
      for (int t = T0; t < a.t1; ++t) {
          const char* kb_ = (const char*)a.K + (size_t)t * 128 * a.ldk; const char* vb_ = (const char*)a.V + (size_t)t * 128 * a.ldv;
          { const unsigned la_ = ldsK + (unsigned)t * 8192u; asm volatile("s_mov_b32 m0, %2\n\ts_nop 0\n\tglobal_load_lds_dwordx4 %0, %1" :: "v"(koff), "s"(kb_), "s"(la_) : "memory", "m0"); }
          { const unsigned la_ = ldsV + (unsigned)t * 8192u; asm volatile("s_mov_b32 m0, %2\n\ts_nop 0\n\tglobal_load_lds_dwordx4 %0, %1" :: "v"(voff), "s"(vb_), "s"(la_) : "memory", "m0"); } } }
    asm volatile("s_waitcnt vmcnt(0)" ::: "memory"); __syncthreads();
#pragma unroll
    for (int t = 0; t < 6; ++t) {
        if (t >= T0 && NEED(t)) { SBAR(); qkt_c128<NQ>(pA0, pA1, KD + t * 8192, qr, r32, hi, negm); mask_tile<MODE>(pA0, pA1, t, n, hi, a); EXP32(pA0, pA1); PACKSUM(pA0, pA1); SBAR();
            pv_d0(o, vbase + t * 8192, pa0, pa1, pa2, pa3); } }
    l_reg = sum32(l_reg);
#undef EXP32
#undef PACKSUM
#undef PK4_
    }
    if (hi == 0) li_l[r32] = l_reg; asm volatile("s_waitcnt lgkmcnt(0)" ::: "memory");
    float rli[16];
#pragma unroll
    for (int r = 0; r < 16; ++r) rli[r] = __builtin_amdgcn_rcpf(li_l[crow(r, hi)]);
    if constexpr (MODE == 0) {
        unsigned char* Ow = (unsigned char*)a.O + (long)(wid * 32) * a.ldo;
        LAS unsigned char* ost = (LAS unsigned char*)(lds + 3 * SHM_K + 3 * SHM_V + 2048) + wid * (32 * 80);
#pragma unroll
        for (int r = 0; r < 16; ++r) { const int orow = crow(r, hi);
#pragma unroll
            for (int d0 = 0; d0 < 2; ++d0) { const float v_ = fminf(fmaxf(8.0f * o[d0][r] * rli[r], -448.f), 448.f); ost[orow * 80 + d0 * 32 + r32] = (unsigned char)(__builtin_amdgcn_cvt_pk_fp8_f32(v_, 0.f, 0, false) & 0xff); } }
        asm volatile("s_waitcnt lgkmcnt(0)" ::: "memory");
#pragma unroll
        for (int it = 0; it < 2; ++it) { const int orow = it * 16 + (lane >> 2), ch = (lane & 3) * 16;
            *(u32x4*)(Ow + (long)orow * a.ldo + ch) = *(const LAS u32x4*)(ost + orow * 80 + ch); }
    } else {
        bf16_t* Ow = a.O + (long)(wid * 32) * a.ldo;
        __syncthreads();
        LAS bf16_t* ost = (LAS bf16_t*)lds + wid * (32 * 72);
#pragma unroll
        for (int r = 0; r < 16; ++r) { const int orow = crow(r, hi);
#pragma unroll
            for (int d0 = 0; d0 < 2; ++d0) ost[orow * 72 + d0 * 32 + r32] = (bf16_t)(cvtpk(o[d0][r] * rli[r], 0.f) & 0xffffu); }
        asm volatile("s_waitcnt lgkmcnt(0)" ::: "memory");
#pragma unroll
        for (int it = 0; it < 4; ++it) { const int orow = it * 8 + (lane >> 3), ch = (lane & 7) * 8;
            *(u32x4*)(Ow + (long)orow * a.ldo + ch) = *(const LAS u32x4*)(ost + orow * 72 + ch); }
    }
    if (MODE == 1) { if (hi == 0) a.lse[(long)n * a.ldlse] = (m_reg + __builtin_amdgcn_logf(l_reg)) * 0.6931471805599453f; }
    __syncthreads();
#undef NEED
#undef SLOAD
#undef SWRITE
#undef SWAIT
#undef RESC
}
#undef KSWZ
#undef SBAR
}

struct KArgs { const float* in[24]; float* out; unsigned char* ws; };
enum { I_X = 0, I_P, I_ATTN_NORM, I_W_IN, I_Q_NORM, I_W_UQ, I_KV_NORM, I_W_UKV, I_W_A, I_W_B, I_W_OUT, I_FFN_NORM, I_W_ROUTER, I_B_ROUTER,
       I_W_GATE, I_B_GATE, I_W_UP, I_B_UP, I_W_DOWN, I_B_DOWN, I_PLE_NORM, I_W_PG, I_W_PP, I_FINAL_NORM };

__device__ __forceinline__ s16x4 tr_rd(int addr) { s16x4 r; asm volatile("ds_read_b64_tr_b16 %0, %1" : "=&v"(r) : "v"(addr) : "memory"); return r; }
__device__ __forceinline__ s16x4 tr_rd1088(int addr) { s16x4 r; asm volatile("ds_read_b64_tr_b16 %0, %1 offset:1088" : "=&v"(r) : "v"(addr) : "memory"); return r; }
__device__ __forceinline__ s16x4 tr_rd1632(int addr) { s16x4 r; asm volatile("ds_read_b64_tr_b16 %0, %1 offset:1632" : "=&v"(r) : "v"(addr) : "memory"); return r; }
__device__ __forceinline__ s16x4 tr_rd544(int addr) { s16x4 r; asm volatile("ds_read_b64_tr_b16 %0, %1 offset:544" : "=&v"(r) : "v"(addr) : "memory"); return r; }
template <bool F8> __device__ __forceinline__ void tr_item(const float* W, int Nsrc, int sc  , const float* gain, void* WTv, int K, int k0, int n0, LAS char* scr, int lane) {
    constexpr int P = 136;
    const int ks = lane >> 4, n4 = (lane & 15) * 4;
    f32x4 v[16];
#pragma unroll
    for (int i = 0; i < 16; ++i) v[i] = sc >= 0 ? *(const f32x4*)(W + (size_t)(k0 + 4 * i + ks) * Nsrc + sc) : (f32x4){0.f, 0.f, 0.f, 0.f};
    if (gain) {
#pragma unroll
        for (int i = 0; i < 16; ++i) v[i] = v[i] * gain[k0 + 4 * i + ks]; }
#pragma unroll
    for (int i = 0; i < 16; ++i) { u32x2 w; w.x = cvtpk(v[i][0], v[i][1]); w.y = cvtpk(v[i][2], v[i][3]); *(LAS u32x2*)(scr + (4 * i + ks) * P + n4 * 2) = w; }
    LDS_WAIT(); asm volatile("" ::: "memory");
    const int g = lane >> 4, i16 = lane & 15, q = i16 >> 2, p = i16 & 3;
    const int rbase = (int)(uintptr_t)scr + q * P + p * 8;
    s16x4 lo[8], hi[8];
#pragma unroll
    for (int t = 0; t < 8; ++t) { const int nblk = t >> 1, c = (t & 1) * 4 + g; const int addr = rbase + 8 * c * P + nblk * 32; lo[t] = tr_rd(addr); hi[t] = tr_rd544(addr); }
    asm volatile("s_waitcnt lgkmcnt(0)" ::: "memory"); __builtin_amdgcn_sched_barrier(0);
#pragma unroll
    for (int t = 0; t < 8; ++t) { const int nblk = t >> 1, c = (t & 1) * 4 + g;
        if constexpr (F8) {
#define BF2F(x) __uint_as_float((unsigned)(unsigned short)(x) << 16)
            u32x2 o; o.x = pk4_fp8(64.f * BF2F(lo[t][0]), 64.f * BF2F(lo[t][1]), 64.f * BF2F(lo[t][2]), 64.f * BF2F(lo[t][3])); o.y = pk4_fp8(64.f * BF2F(hi[t][0]), 64.f * BF2F(hi[t][1]), 64.f * BF2F(hi[t][2]), 64.f * BF2F(hi[t][3]));
#undef BF2F
            *(u32x2*)((unsigned char*)WTv + (size_t)(n0 + nblk * 16 + i16) * K + k0 + 8 * c) = o;
        } else {
        const bf16x8 o = (bf16x8){lo[t][0], lo[t][1], lo[t][2], lo[t][3], hi[t][0], hi[t][1], hi[t][2], hi[t][3]};
        *(bf16x8*)((bf16_t*)WTv + (size_t)(n0 + nblk * 16 + i16) * K + k0 + 8 * c) = o; } }
    asm volatile("" ::: "memory");
}
__device__ __forceinline__ int rope_perm(int p) { const int j = p >> 3, i = p & 7; return (i < 4) ? 4 * j + i : 16 + 4 * j + (i - 4); }
__device__ __forceinline__ void convert_small(const KArgs& a, unsigned char* ws, int layer, LAS char* scr, int gw, int NGW, int lane) {
    constexpr int I_IN = 16 * 80, I_UQ = 6 * 12, I_UKV = 4 * 16, I_A = 8 * 16, I_B = 4 * 16, I_O = 16 * 16, I_PG = 16 * 16, I_PP = 4 * 16;
    constexpr int NIT = I_IN + I_UQ + I_UKV + I_A + I_B + I_O + I_PG + I_PP;
    const int l4 = (lane & 15) * 4;
    for (int it = gw; it < NIT; it += NGW) {
        int r = it;
        if (r < I_IN) { const int kb = r / 80, nb = r % 80, n = nb * 64 + l4; int sc;
            if (n < 256) sc = 384 + n; else if (n < 640) sc = n - 256; else if (n < 672) sc = 640 + rope_perm(n - 640); else if (n < 768) sc = -1; else if (n < 3072) sc = 672 + (n - 768); else sc = 2976 + (n - 3072);
            tr_item<true>(a.in[I_W_IN] + (size_t)layer * DM * IN_COLS, IN_COLS, sc, a.in[I_ATTN_NORM] + layer * DM, (unsigned char*)(ws + WS_WIN) + (size_t)layer * ZC * DM, DM, kb * 64, nb * 64, scr, lane); continue; } r -= I_IN;
        if (r < I_UQ) { const int kb = r / 12, nb = r % 12, n = nb * 64 + l4, h = n / DQK, off = n % DQK; const int sc = h * DQK + (off < DNOPE ? off : DNOPE + rope_perm(off - DNOPE));
            tr_item<false>(a.in[I_W_UQ] + (size_t)layer * QLORA * 768, 768, sc, a.in[I_Q_NORM] + layer * QLORA, (bf16_t*)(ws + WS_WUQ) + (size_t)layer * 768 * QLORA, QLORA, kb * 64, nb * 64, scr, lane); continue; } r -= I_UQ;
        if (r < I_UKV) { const int kb = r / 16, nb = r % 16;
            tr_item<false>(a.in[I_W_UKV] + (size_t)layer * KVLORA * 1024, 1024, nb * 64 + l4, a.in[I_KV_NORM] + layer * KVLORA, (bf16_t*)(ws + WS_WUKV) + (size_t)layer * 1024 * KVLORA, KVLORA, kb * 64, nb * 64, scr, lane); continue; } r -= I_UKV;
        if (r < I_A) { const int kb = r / 16, nb = r % 16;
            tr_item<true>(a.in[I_W_A] + (size_t)layer * 512 * DM, DM, nb * 64 + l4, nullptr, (unsigned char*)(ws + WS_WA) + (size_t)layer * DM * 512, 512, kb * 64, nb * 64, scr, lane); continue; } r -= I_A;
        if (r < I_B) { const int kb = r / 16, nb = r % 16;
            tr_item<true>(a.in[I_W_B] + (size_t)layer * 256 * DM, DM, nb * 64 + l4, nullptr, (unsigned char*)(ws + WS_WB) + (size_t)layer * DM * 256, 256, kb * 64, nb * 64, scr, lane); continue; } r -= I_B;
        if (r < I_O) { const int kb = r / 16, nb = r % 16;
            tr_item<true>(a.in[I_W_OUT] + (size_t)layer * DM * DM, DM, nb * 64 + l4, nullptr, (unsigned char*)(ws + WS_WO) + (size_t)layer * DM * DM, DM, kb * 64, nb * 64, scr, lane); continue; } r -= I_O;
        if (r < I_PG) { const int kb = r / 16, nb = r % 16;
            tr_item<true>(a.in[I_W_PG] + (size_t)layer * DM * DM, DM, nb * 64 + l4, a.in[I_PLE_NORM] + layer * DM, (unsigned char*)(ws + WS_WPG) + (size_t)layer * DM * DM, DM, kb * 64, nb * 64, scr, lane); continue; } r -= I_PG;
        { const int kb = r / 16, nb = r % 16;
            tr_item<false>(a.in[I_W_PP] + (size_t)layer * PLE * DM, DM, nb * 64 + l4, nullptr, (bf16_t*)(ws + WS_WPP) + (size_t)layer * DM * PLE, PLE, kb * 64, nb * 64, scr, lane); }
    }
}
struct CvtItem { const float* src; const float* gain; unsigned char* dst; int sc, k0, n0; };
__device__ __forceinline__ CvtItem expert_item(const KArgs& a, unsigned char* ws, int layer, int it, int l4) {
    constexpr int I_GU = 16 * 32, I_D = 16 * 16, PER_E = I_GU + I_D;
    CvtItem c; const int e = it / PER_E; int r = it % PER_E;
    if (r < I_GU) { const int kb = r / 32, nb = r % 32, n = nb * 64 + l4, pn = n >> 8, j = n & 255;
        c.src = (j < 128 ? a.in[I_W_GATE] : a.in[I_W_UP]) + ((size_t)layer * NE + e) * DM * DE; c.sc = pn * 128 + (j & 127); c.gain = a.in[I_FFN_NORM] + layer * DM;
        c.dst = (unsigned char*)(ws + WS_WGU) + ((size_t)layer * NE + e) * 2048 * DM; c.k0 = kb * 64; c.n0 = nb * 64;
    } else { r -= I_GU; const int kb = r / 16, nb = r % 16;
        c.src = a.in[I_W_DOWN] + ((size_t)layer * NE + e) * DE * DM; c.sc = nb * 64 + l4; c.gain = nullptr; c.dst = (unsigned char*)(ws + WS_WD) + ((size_t)layer * NE + e) * DM * DE; c.k0 = kb * 64; c.n0 = nb * 64; }
    return c;
}
__device__ __forceinline__ void cvt_load(const CvtItem& c, f32x4 (&v)[16], int lane) {
    const int ks = lane >> 4;
#pragma unroll
    for (int i = 0; i < 16; ++i) v[i] = *(const f32x4*)(c.src + (size_t)(c.k0 + 4 * i + ks) * 1024 + c.sc);
}
__device__ __forceinline__ void cvt_finish(const CvtItem& c, f32x4 (&v)[16], LAS char* scr, const LAS float* g64, int lane) {
    constexpr int P = 136;
    const int ks = lane >> 4, n4 = (lane & 15) * 4;
#pragma unroll
    for (int i = 0; i < 16; ++i) { u32x2 w; w.x = cvtpk(v[i][0], v[i][1]); w.y = cvtpk(v[i][2], v[i][3]); *(LAS u32x2*)(scr + (4 * i + ks) * P + n4 * 2) = w; }
    LDS_WAIT(); asm volatile("" ::: "memory");
    const int g = lane >> 4, i16 = lane & 15, q = i16 >> 2, p = i16 & 3;
    const int rbase = (int)(uintptr_t)scr + q * P + p * 8 + 16 * g * P;
    s16x4 r0[4], r1[4], r2[4], r3[4];
#pragma unroll
    for (int t = 0; t < 4; ++t) { const int addr = rbase + t * 32; r0[t] = tr_rd(addr); r1[t] = tr_rd544(addr); r2[t] = tr_rd1088(addr); r3[t] = tr_rd1632(addr); }
    f32x4 q0 = {64.f, 64.f, 64.f, 64.f}, q1 = q0, q2 = q0, q3 = q0;
    if (c.gain) { const LAS f32x4* gp_ = (const LAS f32x4*)(g64 + c.k0 + 16 * g); q0 = gp_[0]; q1 = gp_[1]; q2 = gp_[2]; q3 = gp_[3]; }
    asm volatile("s_waitcnt lgkmcnt(0)" ::: "memory"); __builtin_amdgcn_sched_barrier(0);
#define BF2F(x) __uint_as_float((unsigned)(unsigned short)(x) << 16)
#define PK4S(v, q) pk4_fp8(q[0] * BF2F(v[0]), q[1] * BF2F(v[1]), q[2] * BF2F(v[2]), q[3] * BF2F(v[3]))
#pragma unroll
    for (int t = 0; t < 4; ++t) { u32x4 o; o.x = PK4S(r0[t], q0); o.y = PK4S(r1[t], q1); o.z = PK4S(r2[t], q2); o.w = PK4S(r3[t], q3);
        *(u32x4*)(c.dst + (size_t)(c.n0 + t * 16 + i16) * 1024 + c.k0 + 16 * g) = o; }
#undef PK4S
#undef BF2F
    asm volatile("" ::: "memory");
}
__device__ __forceinline__ void convert_experts(const KArgs& a, unsigned char* ws, int layer, LAS char* scr, LAS float* g64, int tid, int gw, int NGW, int lane) {
    constexpr int NIT = NE * (16 * 32 + 16 * 16);
    const int l4 = (lane & 15) * 4;
    __syncthreads();
    for (int i = tid; i < DM; i += NTHR) g64[i] = 64.0f * a.in[I_FFN_NORM][layer * DM + i];
    __syncthreads();
    int it = gw; if (it >= NIT) return;
    f32x4 vA[16], vB[16];
    CvtItem c0 = expert_item(a, ws, layer, it, l4), c1 = c0; cvt_load(c0, vA, lane);
    for (;;) {
        const int it1 = it + NGW; const bool h1 = it1 < NIT;
        if (h1) { c1 = expert_item(a, ws, layer, it1, l4); cvt_load(c1, vB, lane); }
        cvt_finish(c0, vA, scr, g64, lane);
        if (!h1) break;
        const int it2 = it1 + NGW; const bool h2 = it2 < NIT;
        if (h2) { c0 = expert_item(a, ws, layer, it2, l4); cvt_load(c0, vA, lane); }
        cvt_finish(c1, vB, scr, g64, lane);
        if (!h2) break;
        it = it2;
    }
}

#define LAYER_VARS \
    const float* xin = layer == 0 ? args.in[I_X] : out; (void)xin; \
    float* rsp_attn = rssb + (size_t)RSP_ATTN * T; float* rsp_ffn = rssb + (size_t)RSP_FFN * T; float* rs_ffn = rssb + (size_t)RS_FFNF * T; float* rs_ple = rssb + (size_t)RS_PLE * T; \
    float* rsp_q = rssb + (size_t)RSP_Q * T; float* rsp_kv = rssb + (size_t)RSP_KV * T; float* rs_attn = rssb + (size_t)RS_ATTNF * T; (void)rs_attn; \
    (void)rsp_attn; (void)rsp_ffn; (void)rs_ffn; (void)rs_ple; (void)rsp_q; (void)rsp_kv;
#define GRID_BAR() do { XcdBarrier b2_ = bar; unsigned long long bb_ = (unsigned long long)bar.bar; asm volatile("" : "+s"(bb_), "+s"(b2_.x)); b2_.bar = (unsigned*)(GAS unsigned*)bb_; xcd_barrier(b2_); } while (0)
#define PHASE_VARS \
    unsigned long long ws_ = (unsigned long long)ws0; asm volatile("" : "+s"(ws_)); unsigned char* ws = (unsigned char*)(GAS unsigned char*)ws_; unsigned long long out_ = (unsigned long long)out0; asm volatile("" : "+s"(out_)); float* out = (float*)(GAS float*)out_; \
    int wave = wave0; asm volatile("" : "+s"(wave)); int lane = (int)__builtin_amdgcn_mbcnt_hi(~0u, __builtin_amdgcn_mbcnt_lo(~0u, 0u)); asm volatile("" : "+v"(lane)); const int tid = wave * 64 + lane; \
    int G = G0, bx = bx0; asm volatile("" : "+s"(G), "+s"(bx)); const int vcu = (G % 8 == 0) ? (bx % 8) * (G / 8) + bx / 8 : bx; const int NGW = G * NWAVES, NGT = G * NTHR; (void)NGW; (void)NGT; (void)vcu; \
    const int gw = vcu * NWAVES + wave; const int gtid = vcu * NTHR + tid; (void)gw; (void)gtid; (void)lane; \
    unsigned* ctl = (unsigned*)(ws + WS_CTL); (void)ctl; \
    float* rssb = (float*)(ws + WS_RSS); float* cosT = (float*)(ws + WS_ROPE); float* sinT = cosT + 8192 * 16; (void)rssb; (void)sinT; \
    bf16_t* xbA = (bf16_t*)(ws + WS_XBA); bf16_t* xbB = (bf16_t*)(ws + WS_XBB); bf16_t* pb = (bf16_t*)(ws + WS_PB); bf16_t* ppb = (bf16_t*)(ws + WS_PP); \
    bf16_t* zm = (bf16_t*)(ws + WS_ZM); bf16_t* zd = (bf16_t*)(ws + WS_ZD); bf16_t* gt = (bf16_t*)(ws + WS_GT); \
    bf16_t* qb = (bf16_t*)(ws + WS_Q); bf16_t* kvb = (bf16_t*)(ws + WS_KV); bf16_t* krb = (bf16_t*)(ws + WS_KR); \
    bf16_t* oab = (bf16_t*)(ws + WS_OA); bf16_t* ogb = (bf16_t*)(ws + WS_OG); float* lseb = (float*)(ws + WS_LSE); bf16_t* obb = (bf16_t*)(ws + WS_OB); \
    bf16_t* mixb = (bf16_t*)(ws + WS_MIX); unsigned char* xq = (unsigned char*)(ws + WS_XQ); unsigned char* hm = (unsigned char*)(ws + WS_HM); bf16_t* yb = (bf16_t*)(ws + WS_Y); (void)yb; \
    int* asg = (int*)(ws + WS_ASG); float* tw = (float*)(ws + WS_TW); int* dstrow = (int*)(ws + WS_DST); int* tokl = (int*)(ws + WS_TOKL); float* wl = (float*)(ws + WS_WL); \
    (void)xbA; (void)xbB; (void)pb; (void)ppb; (void)zm; (void)zd; (void)gt; (void)qb; (void)kvb; (void)krb; (void)oab; (void)ogb; (void)lseb; (void)obb; (void)mixb; (void)xq; (void)hm; (void)asg; (void)tw; (void)dstrow; (void)tokl; (void)wl; \
    bf16_t* xb0 = xbA; bf16_t* xb1 = xbB; (void)xb0; (void)xb1; bf16_t* x3b = (bf16_t*)(ws + WS_X3B); (void)x3b;


#define STAMP() do { if (DIAG) { if (threadIdx.x == 0 && blockIdx.x == 0) ((LAS unsigned long long*)(LC + 1024))[nst] = __builtin_amdgcn_s_memrealtime(); ++nst; } } while (0)
template <int LAYER>
__device__ __forceinline__ void layer_body(const KArgs& args, LAS unsigned char* lds, LAS unsigned* LC, unsigned char* const ws0, float* const out0, const int G0, const int bx0, const int wave0, const XcdBarrier& bar, int& nst) {
    constexpr int layer = LAYER;
        if (layer > 0) { { PHASE_VARS LAYER_VARS
            for (int m = gtid; m < T; m += NGT) rs_attn[m] = sum16(rsp_attn + (size_t)m * 16); }
            GRID_BAR(); }
        for (int rep_ = 0; rep_ < NREP(1); ++rep_) if (PH(1)) { if (rep_) GRID_BAR(); PHASE_VARS LAYER_VARS
            pg8::Gemm g{DM, DM, DM, 0x79797979, 0x7d7d7d7d, (unsigned*)(ws + WS_CTL + 524288)}; pg8::DenseSched S; S.init(xb0, DM, (unsigned char*)(ws + WS_WIN) + (size_t)layer * ZC * DM, DM, T, ZC, G, bx);
            pg8::EpiZ E{rs_attn, rsp_q, rsp_kv, zm, zd, gt, krb, cosT, sinT, ctl + CW_KMAX + layer * 192 + 64};
            pg8::gemm_phase<pg8::EpiZ, pg8::DenseSched, true, true>(lds, g, S, E, wave);
        }
        GRID_BAR(); STAMP();

        for (int rep_ = 0; rep_ < NREP(2); ++rep_) if (PH(2)) { if (rep_) GRID_BAR(); PHASE_VARS LAYER_VARS
            { pg8::Gemm g{ZM_LD * 2, QLORA * 2, QLORA * 2, 0, 0, (unsigned*)(ws + WS_CTL + 524288)}; pg8::DenseSched S; S.init(zm + 256, ZM_LD * 2, (bf16_t*)(ws + WS_WUQ) + (size_t)layer * 768 * QLORA, QLORA * 2, T, 768, G, bx);
              pg8::EpiGen<false> E{qb, Q_LD, rsp_q, 2, 1.0f / QLORA, C2_MLA, nullptr, 0, nullptr, 0, nullptr};
              pg8::gemm_phase<pg8::EpiGen<false>, pg8::DenseSched, true>(lds, g, S, E, wave); }
            { pg8::Gemm g{ZM_LD * 2, KVLORA * 2, KVLORA * 2, 0, 0, (unsigned*)(ws + WS_CTL + 524288)}; pg8::DenseSched S; S.init(zm, ZM_LD * 2, (bf16_t*)(ws + WS_WUKV) + (size_t)layer * 1024 * KVLORA, KVLORA * 2, T, 1024, G, bx);
              pg8::EpiGen<true> E{kvb, KV_LD, rsp_kv, 1, 1.0f / KVLORA, 1.0f, nullptr, 0, nullptr, 0, ctl + CW_KMAX + layer * 192};
              pg8::gemm_phase<pg8::EpiGen<true>, pg8::DenseSched, true>(lds, g, S, E, wave); }
            const int per_cu = (1536 + G - 1) / G;
            for (int ui = vcu * per_cu; ui < 1536 && ui < (vcu + 1) * per_cu; ++ui) {
                const int uin = ui & 31, h = (ui >> 5) & 3, gq = (ui >> 7) % 3, b = ui / 384;
                const int dil = gq == 0 ? 1 : (gq == 1 ? 4 : 16); const int nblk = SEQ / (256 * dil); const int r = uin / nblk, u = uin % nblk;
                const long tok0 = (long)b * SEQ + (long)256 * u * dil + r;
                att::Args A;
                A.Q = zd + tok0 * ZD_LD + gq * 768 + h * 64; A.ldq = (long)dil * ZD_LD;
                A.K = zd + (tok0 - (long)128 * dil) * ZD_LD + gq * 768 + 256 + h * 64; A.ldk = (long)dil * ZD_LD; A.K2 = nullptr; A.ldk2 = 0;
                A.V = zd + (tok0 - (long)128 * dil) * ZD_LD + gq * 768 + 512 + h * 64; A.ldv = (long)dil * ZD_LD;
                A.O = ogb + (size_t)gq * T * 256 + tok0 * 256 + h * 64; A.ldo = (long)dil * 256;
                A.lse = lseb + (size_t)gq * T * 4 + tok0 * 4 + h; A.ldlse = (long)dil * 4;
                A.t0 = (u == 0) ? 2 : 0; A.t1 = 6; A.qoff = 128; A.tmask = 0; A.cosT = nullptr; A.sinT = nullptr;
                { const unsigned* kd_ = ctl + CW_KMAX + layer * 192 + 80 + ((b * 3 + gq) * 4 + h) * 2; A.kn = 1.02f * sqrtf(__uint_as_float(kd_[0]) + __uint_as_float(kd_[1])); }
                { const int si = gq * 4 + h;
                  const float ex = si < 8 ? 0.5f * (float)(si + 1) : (float)(si - 3);
                  A.ab = exp2f(-ex) * (float)dil * LOG2E; }
                att::attn_unit<1>(A, (LAS char*)lds, wave);
            }
        }
        GRID_BAR(); STAMP();

        for (int rep_ = 0; rep_ < NREP(3); ++rep_) if (PH(3)) { if (rep_) GRID_BAR(); PHASE_VARS LAYER_VARS
            const int cvt_at = (G == 256) ? ((vcu >> 3) & 3) : -1;
            const int nun = (G == 256) ? 4 : (1024 + G - 1) / G;
            const int isplit = cvt_at < 0 ? nun : cvt_at;
#define P3_UNITS(I0, I1) \
            for (int i = (I0); i < (I1); ++i) { \
                int bh, qblk; \
                if (G == 256) { const int s = vcu & 7; bh = vcu >> 3; qblk = (i == 0) ? 31 - s : (i == 1) ? 16 + s : (i == 2) ? 15 - s : s; } \
                else { const int ui = i * G + vcu; if (ui >= 1024) break; bh = ui >> 5; qblk = ui & 31; } \
                const int b = bh >> 3, h = bh & 7; const long row0 = (long)b * SEQ; \
                att::Args A; \
                A.Q = qb + (row0 + 256 * qblk) * Q_LD + h * DQK; A.ldq = Q_LD; \
                A.K = kvb + row0 * KV_LD + h * 128; A.ldk = KV_LD; A.K2 = krb + row0 * 32; A.ldk2 = 32; \
                A.V = kvb + row0 * KV_LD + h * 128 + 64; A.ldv = KV_LD; \
                A.O = (bf16_t*)((unsigned char*)oab + (row0 + 256 * qblk) * 512 + h * 64); A.ldo = 512; A.lse = nullptr; A.ldlse = 0; \
                A.t0 = 0; A.t1 = 4 * (qblk + 1); A.qoff = 256 * qblk; A.tmask = 4 * qblk; A.ab = 0.f; A.cosT = cosT; A.sinT = sinT; \
                { const unsigned* km_ = ctl + CW_KMAX + layer * 192; \
                  A.kn = 1.02f * sqrtf(__uint_as_float(km_[(b * NH + h) * 2]) + __uint_as_float(km_[(b * NH + h) * 2 + 1]) + __uint_as_float(km_[64 + b])); } \
                att::attn_unit<0>(A, (LAS char*)lds, wave); \
            }
            P3_UNITS(0, isplit)
            if (cvt_at >= 0) { if (layer == 0) { const float* p = args.in[I_P]; const size_t n8 = (size_t)2 * T * PLE / 8;
                  for (size_t i = gtid; i < n8; i += NGT) { const f32x4 a0 = *(const f32x4*)(p + i * 8), a1 = *(const f32x4*)(p + i * 8 + 4); *(u32x4*)(pb + i * 8) = pack8(a0, a1); }
                  convert_small(args, ws, 1, (LAS char*)(lds + wave * 16384), gw, NGW, lane); }
                convert_experts(args, ws, layer, (LAS char*)(lds + wave * 16384), (LAS float*)(lds + RL_OFF), tid, gw, NGW, lane); __syncthreads(); }
            P3_UNITS(isplit, nun)
#undef P3_UNITS
            for (int m = gw; m < T; m += NGW) {
                const int h = lane >> 4;
                const float l0 = lseb[(size_t)0 * T * 4 + (size_t)m * 4 + h], l1 = lseb[(size_t)1 * T * 4 + (size_t)m * 4 + h], l2 = lseb[(size_t)2 * T * 4 + (size_t)m * 4 + h];
                const float mx = fmaxf(l0, fmaxf(l1, l2)); const float e0 = __expf(l0 - mx), e1 = __expf(l1 - mx), e2 = __expf(l2 - mx); const float inv = 1.0f / (e0 + e1 + e2);
                const u32x2 a0 = *(const u32x2*)(ogb + (size_t)0 * T * 256 + (size_t)m * 256 + lane * 4), a1 = *(const u32x2*)(ogb + (size_t)1 * T * 256 + (size_t)m * 256 + lane * 4), a2 = *(const u32x2*)(ogb + (size_t)2 * T * 256 + (size_t)m * 256 + lane * 4);
                const float w0 = e0 * inv, w1 = e1 * inv, w2 = e2 * inv;
                const float r0 = w0 * bflo(a0.x) + w1 * bflo(a1.x) + w2 * bflo(a2.x), r1 = w0 * bfhi(a0.x) + w1 * bfhi(a1.x) + w2 * bfhi(a2.x);
                const float r2 = w0 * bflo(a0.y) + w1 * bflo(a1.y) + w2 * bflo(a2.y), r3 = w0 * bfhi(a0.y) + w1 * bfhi(a1.y) + w2 * bfhi(a2.y);
                *(unsigned*)((unsigned char*)obb + (size_t)m * 256 + lane * 4) = pk4_fp8(8.f * r0, 8.f * r1, 8.f * r2, 8.f * r3);
            }
        }
        GRID_BAR(); STAMP();

        for (int rep_ = 0; rep_ < NREP(5); ++rep_) if (PH(5)) { if (rep_) GRID_BAR(); PHASE_VARS LAYER_VARS
            { pg8::Gemm g{256, 256, 256, 0x79797979, 0x7c7c7c7c, (unsigned*)(ws + WS_CTL + 524288)}; pg8::DenseSched S; S.init(obb, 256, (unsigned char*)(ws + WS_WB) + (size_t)layer * DM * 256, 256, T, DM, G, bx);
              pg8::EpiGen<false> E{mixb, DM, nullptr, 0, 0.f, 1.0f, gt + 1024, GT_LD, nullptr, 0, nullptr};
              pg8::gemm_phase<pg8::EpiGen<false>, pg8::DenseSched, true, true>(lds, g, S, E, wave); }
            { pg8::Gemm g{512, 512, 512, 0x79797979, 0x7c7c7c7c, (unsigned*)(ws + WS_CTL + 524288)}; pg8::DenseSched S; S.init(oab, 512, (unsigned char*)(ws + WS_WA) + (size_t)layer * DM * 512, 512, T, DM, G, bx);
              pg8::EpiGen<false, true> E{(bf16_t*)xq, DM, nullptr, 0, 0.f, 1.0f, gt, GT_LD, mixb, DM, nullptr};
              pg8::gemm_phase<pg8::EpiGen<false, true>, pg8::DenseSched, true, true>(lds, g, S, E, wave); }
            { pg8::Gemm g{PLE * 2, PLE * 2, PLE * 2, 0, 0, (unsigned*)(ws + WS_CTL + 524288)}; pg8::DenseSched S; S.init(pb + (size_t)layer * T * PLE, PLE * 2, (bf16_t*)(ws + WS_WPP) + (size_t)layer * DM * PLE, PLE * 2, T, DM, G, bx);
              pg8::EpiGen<false> E{ppb, DM, nullptr, 0, 0.f, 1.0f, nullptr, 0, nullptr, 0, nullptr};
              pg8::gemm_phase<pg8::EpiGen<false>, pg8::DenseSched, true>(lds, g, S, E, wave); }
        }
        GRID_BAR(); STAMP();

        for (int rep_ = 0; rep_ < NREP(6); ++rep_) if (PH(6)) { if (rep_) GRID_BAR(); PHASE_VARS LAYER_VARS
            pg8::Gemm g{DM, DM, DM, 0x79797979, 0x7c7c7c7c, (unsigned*)(ws + WS_CTL + 524288)}; pg8::DenseSched S; S.init(xq, DM, (unsigned char*)(ws + WS_WO) + (size_t)layer * DM * DM, DM, T, DM, G, bx);
            pg8::EpiRes<false> E{x3b, xb1, nullptr, rsp_ffn, nullptr, nullptr};
            pg8::gemm_phase<pg8::EpiRes<false>, pg8::DenseSched, true, true>(lds, g, S, E, wave);
        }
        GRID_BAR(); STAMP();

        for (int rep_ = 0; rep_ < NREP(7); ++rep_) if (PH(7)) { if (rep_) GRID_BAR(); PHASE_VARS LAYER_VARS
            const bf16_t* wr2 = (const bf16_t*)(ws + WS_WR) + (size_t)layer * 65536;
            const float* brt = args.in[I_B_ROUTER] + layer * NE;
            unsigned* cnt = ctl + CW_CNT + layer * NE;
            LAS float* exch = (LAS float*)lds;
            LAS int* hist = (LAS int*)(LC + LT_HIST); LAS int* base = (LAS int*)(LC + LT_BASE);
            const int tile = wave & 3, kh = wave >> 2, r32 = lane & 31, hi = lane >> 5;
            for (int tb = vcu; tb < T / 128; tb += G) {
                { const char* wsrc = (const char*)wr2; const unsigned voff_ = (unsigned)lane * 16u;
#pragma unroll
                  for (int pc = 0; pc < 16; ++pc) { const unsigned la_ = (unsigned)(uintptr_t)lds + (unsigned)(wave * 16 + pc) * 1024u; const char* sb_ = wsrc + (size_t)(wave * 16 + pc) * 1024;
                      asm volatile("s_mov_b32 m0, %2\n\ts_nop 0\n\tglobal_load_lds_dwordx4 %0, %1" :: "v"(voff_), "s"(sb_), "s"(la_) : "memory", "m0"); }
                  asm volatile("s_waitcnt vmcnt(0)" ::: "memory"); __syncthreads(); }
                const int tok = tb * 128 + tile * 32 + r32;
                const bf16_t* xp = xb1 + (size_t)tok * DM + kh * 512 + 8 * hi;
                const LAS char* wp = (const LAS char*)lds + (size_t)(kh * 32) * 2048 + lane * 16;
                f32x16 acc = {};
#pragma unroll 16
                for (int c = 0; c < 32; ++c) { const bf16x8 xv = *(const bf16x8*)(xp + 16 * c);
                    const bf16x8 wh = *(const LAS bf16x8*)(wp + c * 2048), wl = *(const LAS bf16x8*)(wp + c * 2048 + 1024);
                    acc = __builtin_amdgcn_mfma_f32_32x32x16_bf16(wl, xv, acc, 0, 0, 0); acc = __builtin_amdgcn_mfma_f32_32x32x16_bf16(wh, xv, acc, 0, 0, 0); }
                __syncthreads();
                if (kh == 1) {
#pragma unroll
                    for (int r = 0; r < 16; ++r) exch[(tile * 16 + r) * 64 + lane] = acc[r]; }
                __syncthreads();
                int idx[4] = {0, 0, 0, 0}; float wgt[4] = {0.f, 0.f, 0.f, 0.f}; int lrank[4] = {0, 0, 0, 0};
                if (kh == 0) {
                    const float rsum = sum16(rsp_ffn + (size_t)tok * 16); if (hi == 0) rs_ffn[tok] = rsum;
                    const float rstd = __builtin_amdgcn_rsqf(rsum * (1.0f / DM) + EPS);
                    float v[16];
#pragma unroll
                    for (int r = 0; r < 16; ++r) v[r] = (acc[r] + exch[(tile * 16 + r) * 64 + lane]) * rstd + brt[crow(r, hi)];
                    float tv[4]; int ti[4];
#pragma unroll
                    for (int t = 0; t < 4; ++t) { float best = -INFINITY; int bi = 0;
#pragma unroll
                        for (int r = 0; r < 16; ++r) { if (v[r] > best) { best = v[r]; bi = r; } }
                        tv[t] = best; ti[t] = crow(bi, hi);
#pragma unroll
                        for (int r = 0; r < 16; ++r) v[r] = (r == bi) ? -INFINITY : v[r]; }
                    float cv[8]; int ci[8];
#pragma unroll
                    for (int t = 0; t < 4; ++t) { auto rv = __builtin_amdgcn_permlane32_swap(__float_as_uint(tv[t]), __float_as_uint(tv[t]), false, false); auto ri = __builtin_amdgcn_permlane32_swap((unsigned)ti[t], (unsigned)ti[t], false, false);
                        cv[t] = __uint_as_float(rv[0]); ci[t] = (int)ri[0]; cv[4 + t] = __uint_as_float(rv[1]); ci[4 + t] = (int)ri[1]; }
#pragma unroll
                    for (int t = 0; t < 4; ++t) { float best = -INFINITY; int be = 1 << 30; int bi = 0;
#pragma unroll
                        for (int r = 0; r < 8; ++r) { if (cv[r] > best || (cv[r] == best && ci[r] < be)) { best = cv[r]; be = ci[r]; bi = r; } }
                        wgt[t] = best; idx[t] = be;
#pragma unroll
                        for (int r = 0; r < 8; ++r) cv[r] = (r == bi) ? -INFINITY : cv[r]; }
                    const float e1 = __expf(wgt[1] - wgt[0]), e2 = __expf(wgt[2] - wgt[0]), e3 = __expf(wgt[3] - wgt[0]); const float inv = 1.0f / (1.0f + e1 + e2 + e3);
                    wgt[0] = inv; wgt[1] = e1 * inv; wgt[2] = e2 * inv; wgt[3] = e3 * inv;
                    if (hi == 0) {
#pragma unroll
                        for (int t = 0; t < 4; ++t) lrank[t] = __hip_atomic_fetch_add(hist + idx[t], 1, __ATOMIC_RELAXED, __HIP_MEMORY_SCOPE_WORKGROUP); }
                }
                __syncthreads();
                if (tid < NE) { const int hcount = hist[tid]; base[tid] = (int)__hip_atomic_fetch_add(cnt + tid, (unsigned)hcount, __ATOMIC_RELAXED, __HIP_MEMORY_SCOPE_AGENT); hist[tid] = 0; }
                __syncthreads();
                if (kh == 0 && hi == 0) {
#pragma unroll
                    for (int t = 0; t < 4; ++t) { const int slot = base[idx[t]] + lrank[t]; asg[(size_t)tok * 4 + t] = (idx[t] << 16) | slot;
                        tokl[(size_t)idx[t] * 32768 + slot] = tok; wl[(size_t)idx[t] * 32768 + slot] = wgt[t]; } }
                for (int i0 = 0; i0 < 16; i0 += 4) {
                    float scv[4]; u32x4 a0v[4], a1v[4];
#pragma unroll
                    for (int i = 0; i < 4; ++i) { const int m = tb * 128 + wave * 16 + i0 + i;
                        scv[i] = sum16(rsp_ffn + (size_t)m * 16); a0v[i] = *(const u32x4*)(xb1 + (size_t)m * DM + lane * 8); a1v[i] = *(const u32x4*)(xb1 + (size_t)m * DM + 512 + lane * 8); }
#pragma unroll
                    for (int i = 0; i < 4; ++i) { const int m = tb * 128 + wave * 16 + i0 + i;
                        const float sc = __builtin_amdgcn_rsqf(scv[i] * (1.0f / DM) + EPS) * 8.0f;
                        f32x4 f0, f1, f2, f3; unpack8(a0v[i], f0, f1); unpack8(a1v[i], f2, f3); f0 = f0 * sc; f1 = f1 * sc; f2 = f2 * sc; f3 = f3 * sc;
                        u32x2 w0, w1; w0.x = pk4_fp8(f0[0], f0[1], f0[2], f0[3]); w0.y = pk4_fp8(f1[0], f1[1], f1[2], f1[3]); w1.x = pk4_fp8(f2[0], f2[1], f2[2], f2[3]); w1.y = pk4_fp8(f3[0], f3[1], f3[2], f3[3]);
                        *(u32x2*)(xq + (size_t)m * DM + lane * 8) = w0; *(u32x2*)(xq + (size_t)m * DM + 512 + lane * 8) = w1; }
                }
                __syncthreads();
            }
        }
        GRID_BAR(); STAMP();

        for (int rep_ = 0; rep_ < NREP(9); ++rep_) if (PH(9)) { if (rep_) GRID_BAR(); PHASE_VARS LAYER_VARS
            LAS int* ucum = (LAS int*)(LC + LT_UCUM); LAS int* rb0 = (LAS int*)(LC + LT_RB0); LAS int* cntl = (LAS int*)(LC + LT_HIST);
            LAS unsigned short* rowlist = (LAS unsigned short*)(lds + RL_OFF);
            const unsigned* cnt = ctl + CW_CNT + layer * NE;
            if (tid < NE) cntl[tid] = (int)__hip_atomic_load(cnt + tid, __ATOMIC_RELAXED, __HIP_MEMORY_SCOPE_AGENT);
            __syncthreads();
            if (tid == 0) { int rb = 0, uc = 0; for (int e = 0; e < NE; ++e) { const int nb = (cntl[e] + 255) >> 8; rb0[e] = rb; ucum[e] = uc; rb += nb; uc += nb * 8; } rb0[NE] = rb; ucum[NE] = uc; }
            __syncthreads();
            pg8::Gemm g{DM, DM, DM, 0x79797979, 0x7c7c7c7c, (unsigned*)(ws + WS_CTL + 524288)};
            pg8::MoeSched S{(const char*)xq, (const char*)(ws + WS_WGU) + (size_t)layer * NE * 2048 * DM, (size_t)256 * DM, (size_t)256 * DM, (size_t)2048 * DM, 8, G, bx, ucum, rb0, true};
            {
                pg8::Unit u;
                for (int i = wave; i < 17 && S.next(i, u); i += NWAVES) {
#pragma unroll
                    for (int rr = 0; rr < 4; ++rr) { const int r_ = rr * 64 + lane; const int slot = u.rl * 256 + r_; rowlist[i * 256 + r_] = (unsigned short)(slot < cntl[u.aux] ? tokl[(size_t)u.aux * 32768 + slot] : 0); } }
            }
            __syncthreads();
            pg8::EpiSwiglu E{hm, args.in[I_B_GATE] + (size_t)layer * NE * DE, args.in[I_B_UP] + (size_t)layer * NE * DE};
            pg8::gemm_phase<pg8::EpiSwiglu, pg8::MoeSched, true, true, true>(lds, g, S, E, wave, rowlist);
            for (int e = tid; e < NE; e += NTHR) cntl[e] = 0;
        }
        GRID_BAR(); STAMP();

        for (int rep_ = 0; rep_ < NREP(10); ++rep_) if (PH(10)) { if (rep_) GRID_BAR(); PHASE_VARS LAYER_VARS
            LAS int* ucum = (LAS int*)(LC + LT_UCUM); LAS int* rb0 = (LAS int*)(LC + LT_RB0);
            __syncthreads();
            if (tid == 0) { int uc = 0; for (int e = 0; e < NE; ++e) { ucum[e] = uc; uc += (rb0[e + 1] - rb0[e]) * 4; } ucum[NE] = uc; }
            __syncthreads();
            pg8::Gemm g{DE, DE, DE, 0x79797979, 0x7d7d7d7d, (unsigned*)(ws + WS_CTL + 524288)};
            pg8::MoeSched S{(const char*)hm, (const char*)(ws + WS_WD) + (size_t)layer * NE * DM * DE, (size_t)256 * DE, (size_t)256 * DE, (size_t)DM * DE, 4, G, bx, ucum, rb0, false};
            pg8::EpiDown E{(unsigned char*)yb, wl, args.in[I_B_DOWN] + (size_t)layer * NE * DM};
            pg8::gemm_phase<pg8::EpiDown, pg8::MoeSched, true, true>(lds, g, S, E, wave);
        }
        GRID_BAR(); STAMP();

        for (int rep_ = 0; rep_ < NREP(11); ++rep_) if (PH(11)) { if (rep_) GRID_BAR(); PHASE_VARS LAYER_VARS
            const LAS int* rb0p = (const LAS int*)(LC + LT_RB0);
            const unsigned char* y8 = (const unsigned char*)yb;
            for (int m = gw; m < T; m += NGW) {
                f32x4 v0, v1, v2, v3; unpack8(*(const u32x4*)(xb1 + (size_t)m * DM + lane * 8), v0, v1); unpack8(*(const u32x4*)(xb1 + (size_t)m * DM + 512 + lane * 8), v2, v3);
                f32x4 s0 = {0.f, 0.f, 0.f, 0.f}, s1 = s0, s2 = s0, s3 = s0;
#pragma unroll
                for (int t = 0; t < 4; ++t) { const int as_ = asg[(size_t)m * 4 + t]; const int dst = rb0p[as_ >> 16] * 256 + (as_ & 0xffff);
                    const u32x2 ya = *(const u32x2*)(y8 + (size_t)dst * DM + lane * 8), yc = *(const u32x2*)(y8 + (size_t)dst * DM + 512 + lane * 8);
                    s0 = s0 + unpack4_fp8(ya.x); s1 = s1 + unpack4_fp8(ya.y); s2 = s2 + unpack4_fp8(yc.x); s3 = s3 + unpack4_fp8(yc.y); }
                v0 = v0 + s0 * 0.125f; v1 = v1 + s1 * 0.125f; v2 = v2 + s2 * 0.125f; v3 = v3 + s3 * 0.125f;
                *(u32x4*)(xb1 + (size_t)m * DM + lane * 8) = pack8(v0, v1); *(u32x4*)(xb1 + (size_t)m * DM + 512 + lane * 8) = pack8(v2, v3);
                { u32x2 w0, w1; w0.x = pk4_fp8(4.f * v0[0], 4.f * v0[1], 4.f * v0[2], 4.f * v0[3]); w0.y = pk4_fp8(4.f * v1[0], 4.f * v1[1], 4.f * v1[2], 4.f * v1[3]);
                  w1.x = pk4_fp8(4.f * v2[0], 4.f * v2[1], 4.f * v2[2], 4.f * v2[3]); w1.y = pk4_fp8(4.f * v3[0], 4.f * v3[1], 4.f * v3[2], 4.f * v3[3]);
                  *(u32x2*)(xq + (size_t)m * DM + lane * 8) = w0; *(u32x2*)(xq + (size_t)m * DM + 512 + lane * 8) = w1; }
                float s = 0.f;
#pragma unroll
                for (int i = 0; i < 4; ++i) s += v0[i] * v0[i] + v1[i] * v1[i] + v2[i] * v2[i] + v3[i] * v3[i];
                s = wave_sum(s);
                if (lane == 0) rs_ple[m] = s;
            }
            if (layer == 0 && G != 256) { __syncthreads(); convert_experts(args, ws, 1, (LAS char*)(lds + wave * 16384), (LAS float*)(lds + RL_OFF), tid, gw, NGW, lane); }
        }
        GRID_BAR(); STAMP();

        for (int rep_ = 0; rep_ < NREP(12); ++rep_) if (PH(12)) { if (rep_) GRID_BAR(); PHASE_VARS LAYER_VARS
            pg8::Gemm g{DM, DM, DM, 0x79797979, 0x7d7d7d7d, (unsigned*)(ws + WS_CTL + 524288)}; pg8::DenseSched S; S.init(xq, DM, (unsigned char*)(ws + WS_WPG) + (size_t)layer * DM * DM, DM, T, DM, G, bx);
            pg8::EpiRes<true> E{xb1, x3b, layer == 0 ? (unsigned char*)xb0 : nullptr, rsp_attn, rs_ple, ppb};
            pg8::gemm_phase<pg8::EpiRes<true>, pg8::DenseSched, true, true>(lds, g, S, E, wave);
        }
        GRID_BAR(); STAMP();
    }

__global__ void __launch_bounds__(NTHR, 2) mega_fwd(KArgs args) {
    extern __shared__ __attribute__((aligned(16))) unsigned char lds_raw[];
    LAS unsigned char* lds = (LAS unsigned char*)lds_raw;
    LAS unsigned* LC = (LAS unsigned*)(lds + LDSCTL_OFF);
    const int tid0 = threadIdx.x; const int wave0 = __builtin_amdgcn_readfirstlane(tid0 >> 6);
    const int G0 = gridDim.x; const int bx0 = blockIdx.x;
    unsigned char* const ws0 = args.ws; float* const out0 = args.out;
    for (int u = tid0; u < (LDS_BYTES - LDSCTL_OFF) / 4; u += NTHR) LC[u] = 0u;
    __syncthreads();
    XcdBarrier bar = xcd_barrier_post((unsigned*)(ws0 + WS_CTL) + CW_BAR, (volatile LAS unsigned*)(LC + 8));
    int nst = 0; (void)nst;
    STAMP();
    for (int rep_ = 0; rep_ < NREP(0); ++rep_) if (PH(0)) { if (rep_) GRID_BAR(); PHASE_VARS
        LAS char* scr = (LAS char*)(lds + wave * 16384);
        const float* x = args.in[I_X];
        for (int m = gw; m < T; m += NGW) {
            const f32x4* xr = (const f32x4*)(x + (size_t)m * DM) + lane; f32x4 v[4]; float s = 0.f;
#pragma unroll
            for (int j = 0; j < 4; ++j) { v[j] = xr[64 * j]; s += (v[j].x * v[j].x + v[j].y * v[j].y) + (v[j].z * v[j].z + v[j].w * v[j].w); }
            s = wave_sum(s);
            unsigned* o4 = (unsigned*)((unsigned char*)xbA + (size_t)m * DM) + lane;
#pragma unroll
            for (int j = 0; j < 4; ++j) o4[64 * j] = pk4_fp8(4.f * v[j].x, 4.f * v[j].y, 4.f * v[j].z, 4.f * v[j].w);
            if (lane == 0) rssb[(size_t)RS_ATTNF * T + m] = s;
            { u32x2* o8 = (u32x2*)(x3b + (size_t)m * DM) + lane;
#pragma unroll
              for (int j = 0; j < 4; ++j) { u32x2 w; w.x = cvtpk(v[j].x, v[j].y); w.y = cvtpk(v[j].z, v[j].w); o8[64 * j] = w; } }
        }
        if (G != 256) { const float* p = args.in[I_P]; const size_t n8 = (size_t)2 * T * PLE / 8;
          for (size_t i = gtid; i < n8; i += NGT) { const f32x4 a0 = *(const f32x4*)(p + i * 8), a1 = *(const f32x4*)(p + i * 8 + 4); *(u32x4*)(pb + i * 8) = pack8(a0, a1); } }
        for (int i = gtid; i < 8192 * 16; i += NGT) { const int pos = i >> 4, f = i & 15; const float inv = powf(10000.0f, -(float)f * 2.0f / 32.0f); const float ang = (float)pos * inv; cosT[i] = cosf(ang); sinT[i] = sinf(ang); }
        for (int i = gtid; i < 2 * 32768; i += NGT) { const int l = i >> 15, r = i & 32767, st = r >> 9, ln = (r >> 3) & 63, j = r & 7; const int k = 16 * st + 8 * (ln >> 5) + j, e = ln & 31;
            const float w = args.in[I_FFN_NORM][l * DM + k] * args.in[I_W_ROUTER][((size_t)l * DM + k) * NE + e];
            const unsigned h_ = cvtpk(w, 0.f) & 0xffffu; const unsigned l_ = cvtpk(w - __uint_as_float(h_ << 16), 0.f) & 0xffffu;
            bf16_t* wr3 = (bf16_t*)(ws + WS_WR) + ((size_t)(l * 64 + st) * 2 * 64 + ln) * 8 + j;
            wr3[0] = (bf16_t)h_; wr3[512] = (bf16_t)l_; }
        convert_small(args, ws, 0, scr, gw, NGW, lane);
        if (G != 256) convert_small(args, ws, 1, scr, gw, NGW, lane);
        if (G != 256) convert_experts(args, ws, 0, scr, (LAS float*)(lds + RL_OFF), tid, gw, NGW, lane);
    }
    GRID_BAR(); STAMP();

    layer_body<0>(args, lds, LC, ws0, out0, G0, bx0, wave0, bar, nst);
    layer_body<1>(args, lds, LC, ws0, out0, G0, bx0, wave0, bar, nst);

    for (int rep_ = 0; rep_ < NREP(13); ++rep_) if (PH(13)) { if (rep_) GRID_BAR(); PHASE_VARS
        const float* fg = args.in[I_FINAL_NORM];
        const unsigned bad = __hip_atomic_load(ctl + CW_BAR + XB_TMO, __ATOMIC_RELAXED, __HIP_MEMORY_SCOPE_AGENT);
        for (int m = gw; m < T; m += NGW) {
            f32x4 v[4]; unpack8(*(const u32x4*)(x3b + (size_t)m * DM + lane * 8), v[0], v[1]); unpack8(*(const u32x4*)(x3b + (size_t)m * DM + 512 + lane * 8), v[2], v[3]);
            float s = 0.f;
#pragma unroll
            for (int j = 0; j < 4; ++j) s += (v[j].x * v[j].x + v[j].y * v[j].y) + (v[j].z * v[j].z + v[j].w * v[j].w);
            s = wave_sum(s);
            float rstd = __builtin_amdgcn_rsqf(s * (1.0f / DM) + EPS);
            if (bad) rstd = __builtin_nanf("");
            float* orow = out + (size_t)m * DM;
            *(f32x4*)(orow + lane * 8) = v[0] * rstd * *(const f32x4*)(fg + lane * 8); *(f32x4*)(orow + lane * 8 + 4) = v[1] * rstd * *(const f32x4*)(fg + lane * 8 + 4);
            *(f32x4*)(orow + 512 + lane * 8) = v[2] * rstd * *(const f32x4*)(fg + 512 + lane * 8); *(f32x4*)(orow + 512 + lane * 8 + 4) = v[3] * rstd * *(const f32x4*)(fg + 512 + lane * 8 + 4);
        }
    }
#if DIAG
    {
        GRID_BAR(); STAMP();
        PHASE_VARS
        if (bx == 0 && tid == 0) {
            LAS unsigned long long* ts = (LAS unsigned long long*)(LC + 1024);
            const int kinds[11] = {1, 2, 3, 5, 6, 7, 8, 9, 10, 11, 12};
            const float total = (float)(ts[24] - ts[0]); float A = 0.f, B = 0.f;
            for (int i = 1; i <= 24; ++i) { const int kind = (i == 1) ? 0 : (i == 24) ? 13 : kinds[(i - 2) % 11]; const float d = (float)(ts[i] - ts[i - 1]);
                if ((DIAG_A_MASK >> kind) & 1u) A += d; if ((DIAG_B_MASK >> kind) & 1u) B += d; }
            A = A / total * 1000.f; B = B / total * 1000.f;
            const float c = exp10f(A / 40.f), dd = c * exp10f(0.5f + B / 400.f);
            ((float*)ctl)[2048] = c; ((float*)ctl)[2049] = dd;
        }
        GRID_BAR();
        const float c = ((volatile float*)ctl)[2048], dd = ((volatile float*)ctl)[2049];
        for (size_t i = gtid; i < (size_t)T * DM; i += NGT) out[i] = (i == 0) ? dd : c;
    }
#endif
}

extern "C" void kernel_launch(void* const* d_in, const int* in_sizes, int n_in, void* d_out, int out_size, void* d_ws, size_t ws_size, hipStream_t stream) {
    static int grid = 0;
    if (grid == 0) {
        if (n_in != 24 || out_size != T * DM || ws_size < WS_END) { fprintf(stderr, "kernel_launch: shape mismatch n_in %d out %d ws %zu (need %zu)\n", n_in, out_size, ws_size, (size_t)WS_END); grid = -1; return; }
        int dev = 0, cus = 0, per_cu = 0;
        if (hipGetDevice(&dev) != hipSuccess || hipDeviceGetAttribute(&cus, hipDeviceAttributeMultiprocessorCount, dev) != hipSuccess) { grid = -1; return; }
        if (hipFuncSetAttribute((const void*)mega_fwd, hipFuncAttributeMaxDynamicSharedMemorySize, LDS_BYTES) != hipSuccess) { fprintf(stderr, "kernel_launch: hipFuncSetAttribute failed\n"); grid = -1; return; }
        if (hipOccupancyMaxActiveBlocksPerMultiprocessor(&per_cu, (const void*)mega_fwd, NTHR, LDS_BYTES) != hipSuccess || per_cu < 1) { fprintf(stderr, "kernel_launch: occupancy query says %d\n", per_cu); }
        (void)hipGetLastError();
        grid = cus;
    }
    if (grid < 0) return;
    if (hipMemsetAsync((char*)d_ws + WS_CTL, 0, ZERO_BYTES, stream) != hipSuccess) return;
    KArgs a{};
    for (int i = 0; i < 24; ++i) a.in[i] = (const float*)d_in[i];
    a.out = (float*)d_out; a.ws = (unsigned char*)d_ws;
    hipLaunchKernelGGL(mega_fwd, dim3(grid), dim3(NTHR), LDS_BYTES, stream, a);
}
```
